# Optimizing an MI355X kernel written in HIP

```python
import math
import jax, jax.numpy as jnp
from jax import lax
import numpy as np

D_MODEL = 1024
BATCH = 2
SEQ = 16384
DEPTH = 2

GRID_W = 64
CTX_LEN = 256
BLK = 128
WINDOW = 128
ROPE_BASE = 10000.0
EPS = 1e-6
NEG = -1e30

A_HEADS = 8
A_KV = 2
A_DH = 64
B_GROUPS = 4
B_DG = 64
B_CHUNK = 128
C_HEADS = 4
C_DQ = 32
C_DV = 64

D_MIX = A_HEADS * A_DH + B_GROUPS * B_DG + C_HEADS * C_DV
OFF_AQ = 0
OFF_AK = OFF_AQ + A_HEADS * A_DH
OFF_AV = OFF_AK + A_KV * A_DH
OFF_BU = OFF_AV + A_KV * A_DH
OFF_BV = OFF_BU + B_GROUPS * B_DG
OFF_CQ = OFF_BV + B_GROUPS * B_DG
OFF_CK = OFF_CQ + C_HEADS * 2 * C_DQ
OFF_CV = OFF_CK + C_HEADS * 2 * C_DQ
D_IN = OFF_CV + C_HEADS * C_DV

MOE_GROUPS = 4
MOE_PER_GROUP = 4
N_EXPERTS = MOE_GROUPS * MOE_PER_GROUP
MOE_TOPK = 2
D_EXPERT = 512

kernel_name = 'hybrid_parallel_group_dit_block'


def rmsnorm(x, g):
    xf = x.astype(jnp.float32)
    y = xf * lax.rsqrt(jnp.mean(xf * xf, axis=-1, keepdims=True) + EPS)
    return (y * g.astype(jnp.float32)).astype(x.dtype)


def axial_rope(x, rows, cols):
    dh = x.shape[-1]
    n = dh // 4
    inv = ROPE_BASE ** (-jnp.arange(n, dtype=jnp.float32) / n)
    xf = x.astype(jnp.float32)

    def rot(xp, pos):
        ang = pos[:, None] * inv
        cs = jnp.cos(ang)[None, :, None, :]
        sn = jnp.sin(ang)[None, :, None, :]
        x1, x2 = xp[..., :n], xp[..., n:]
        return jnp.concatenate([x1 * cs - x2 * sn, x1 * sn + x2 * cs], axis=-1)

    out = jnp.concatenate([rot(xf[..., :2 * n], rows), rot(xf[..., 2 * n:], cols)], axis=-1)
    return out.astype(x.dtype)


def _sink_probs(scores, sink):
    m = sink
    for s in scores:
        m = jnp.maximum(m, jnp.max(s, axis=-1, keepdims=True))
    es = [jnp.exp(s - m) for s in scores]
    den = jnp.exp(sink - m)
    for e in es:
        den = den + jnp.sum(e, axis=-1, keepdims=True)
    return [e / den for e in es]


def window_sink_attn(q, k, v, kc, vc, sink):
    Bn, S, Hq, dh = q.shape
    Hkv = k.shape[2]
    G = Hq // Hkv
    nb = S // BLK
    scale = dh ** -0.5
    qb = q.reshape(Bn, nb, BLK, Hkv, G, dh)

    def band(t):
        tp = jnp.pad(t, ((0, 0), (BLK, BLK), (0, 0), (0, 0))).reshape(Bn, nb + 2, BLK, Hkv, dh)
        return jnp.concatenate([tp[:, :-2], tp[:, 1:-1], tp[:, 2:]], axis=2)

    kb, vb = band(k), band(v)
    s_loc = jnp.einsum('bnqhgd,bnkhd->bnhgqk', qb, kb).astype(jnp.float32) * scale
    bi = jnp.arange(nb)[:, None, None]
    qpos = bi * BLK + jnp.arange(BLK)[None, :, None]
    kpos = (bi - 1) * BLK + jnp.arange(3 * BLK)[None, None, :]
    mask = (jnp.abs(kpos - qpos) <= WINDOW) & (kpos >= 0) & (kpos < S)
    s_loc = jnp.where(mask[None, :, None, None], s_loc, NEG)
    s_ctx = jnp.einsum('bnqhgd,bchd->bnhgqc', qb, kc).astype(jnp.float32) * scale
    p_loc, p_ctx = _sink_probs([s_loc, s_ctx], sink.astype(jnp.float32).reshape(Hkv, G, 1, 1))
    o = (jnp.einsum('bnhgqk,bnkhd->bnqhgd', p_loc.astype(v.dtype), vb)
         + jnp.einsum('bnhgqc,bchd->bnqhgd', p_ctx.astype(v.dtype), vc))
    return o.reshape(Bn, S, Hq * dh)


def ctx_sink_attn(qc, kc, vc, sink):
    Bn, L, Hq, dh = qc.shape
    Hkv = kc.shape[2]
    G = Hq // Hkv
    qg = qc.reshape(Bn, L, Hkv, G, dh)
    s = jnp.einsum('bqhgd,bkhd->bhgqk', qg, kc).astype(jnp.float32) * dh ** -0.5
    (p,) = _sink_probs([s], sink.astype(jnp.float32).reshape(Hkv, G, 1, 1))
    o = jnp.einsum('bhgqk,bkhd->bqhgd', p.astype(vc.dtype), vc)
    return o.reshape(Bn, L, Hq * dh)


def chunk_gmlp(u, v, ws, bs, gtok):
    Bn, L, _ = u.shape
    nc = L // B_CHUNK
    u = jax.nn.gelu(u).reshape(Bn, nc, B_CHUNK, B_GROUPS, B_DG)
    vf = jax.nn.gelu(v).astype(jnp.float32).reshape(Bn, nc, B_CHUNK, B_GROUPS, B_DG)
    mu = jnp.mean(vf, axis=-1, keepdims=True)
    var = jnp.mean(jnp.square(vf - mu), axis=-1, keepdims=True)
    vn = ((vf - mu) * lax.rsqrt(var + EPS) * gtok.astype(jnp.float32)).astype(u.dtype)
    s = jnp.einsum('gpq,bnqgd->bnpgd', ws, vn) + bs.T[:, :, None]
    return (u * s).reshape(Bn, L, B_GROUPS * B_DG)


def _diff_core(q1, q2, k1, k2, v, lam):
    scale = C_DQ ** -0.5
    p1 = jax.nn.softmax(jnp.einsum('bqhd,bkhd->bhqk', q1, k1).astype(jnp.float32) * scale, axis=-1)
    p2 = jax.nn.softmax(jnp.einsum('bqhd,bkhd->bhqk', q2, k2).astype(jnp.float32) * scale, axis=-1)
    w = p1 - lam * p2
    return jnp.einsum('bhqk,bkhe->bqhe', w.astype(v.dtype), v)


def diff_attn(q1, q2, k1, k2, v, lam):
    Bn, Lq, H, dq = q1.shape
    nb = Lq // BLK
    qb1 = q1.reshape(Bn, nb, BLK, H, dq).swapaxes(0, 1)
    qb2 = q2.reshape(Bn, nb, BLK, H, dq).swapaxes(0, 1)
    out = lax.map(lambda qs: _diff_core(qs[0], qs[1], k1, k2, v, lam), (qb1, qb2))
    return out.swapaxes(0, 1).reshape(Bn, Lq, H, v.shape[-1])


def diff_out(o, gsub, lam_init):
    Bn, L, H, dv = o.shape
    return (rmsnorm(o, gsub) * (1.0 - lam_init)).reshape(Bn, L, H * dv)


def token_mixers(h, hc, w_in, w_out, sink, ws, bs, gtok, gsub, lam, lam_init, rows, cols, ctx_out):
    Bn, S, _ = h.shape
    Lc = hc.shape[1]
    p = h @ w_in

    def heads(lo, hi, n, d):
        return p[..., lo:hi].reshape(Bn, S, n, d)

    def cproj(lo, hi, n, d):
        return (hc @ w_in[:, lo:hi]).reshape(Bn, Lc, n, d)

    qa = axial_rope(heads(OFF_AQ, OFF_AK, A_HEADS, A_DH), rows, cols)
    ka = axial_rope(heads(OFF_AK, OFF_AV, A_KV, A_DH), rows, cols)
    va = heads(OFF_AV, OFF_BU, A_KV, A_DH)
    ka_c = cproj(OFF_AK, OFF_AV, A_KV, A_DH)
    va_c = cproj(OFF_AV, OFF_BU, A_KV, A_DH)
    ya = window_sink_attn(qa, ka, va, ka_c, va_c, sink)
    yb = chunk_gmlp(p[..., OFF_BU:OFF_BV], p[..., OFF_BV:OFF_CQ], ws, bs, gtok)
    qd = axial_rope(heads(OFF_CQ, OFF_CK, 2 * C_HEADS, C_DQ), rows, cols).reshape(Bn, S, C_HEADS, 2, C_DQ)
    kd = axial_rope(heads(OFF_CK, OFF_CV, 2 * C_HEADS, C_DQ), rows, cols).reshape(Bn, S, C_HEADS, 2, C_DQ)
    vd = heads(OFF_CV, D_IN, C_HEADS, C_DV)
    kd_c = cproj(OFF_CK, OFF_CV, 2 * C_HEADS, C_DQ).reshape(Bn, Lc, C_HEADS, 2, C_DQ)
    vd_c = cproj(OFF_CV, D_IN, C_HEADS, C_DV)
    k1 = jnp.concatenate([kd_c[..., 0, :], kd[..., 0, :]], axis=1)
    k2 = jnp.concatenate([kd_c[..., 1, :], kd[..., 1, :]], axis=1)
    vall = jnp.concatenate([vd_c, vd], axis=1)
    yc = diff_out(diff_attn(qd[..., 0, :], qd[..., 1, :], k1, k2, vall, lam), gsub, lam_init)
    y = jnp.concatenate([ya, yb, yc], axis=-1) @ w_out
    if not ctx_out:
        return y, None
    ya_c = ctx_sink_attn(cproj(OFF_AQ, OFF_AK, A_HEADS, A_DH), ka_c, va_c, sink)
    yb_c = chunk_gmlp(hc @ w_in[:, OFF_BU:OFF_BV], hc @ w_in[:, OFF_BV:OFF_CQ], ws, bs, gtok)
    qd_c = cproj(OFF_CQ, OFF_CK, 2 * C_HEADS, C_DQ).reshape(Bn, Lc, C_HEADS, 2, C_DQ)
    yc_c = diff_out(diff_attn(qd_c[..., 0, :], qd_c[..., 1, :], kd_c[..., 0, :], kd_c[..., 1, :], vd_c, lam), gsub, lam_init)
    y_c = jnp.concatenate([ya_c, yb_c, yc_c], axis=-1) @ w_out
    return y, y_c


def hier_moe(h, w_rg, b_rg, w_re, b_re, w_gate, w_up, w_down):
    Bn, L, D = h.shape
    t = h.reshape(-1, D)
    pg = jax.nn.softmax((t @ w_rg).astype(jnp.float32) + b_rg.astype(jnp.float32), axis=-1)
    ptop, gsel = lax.top_k(pg, 1)
    le = ((t @ w_re).astype(jnp.float32) + b_re.astype(jnp.float32)).reshape(-1, MOE_GROUPS, MOE_PER_GROUP)
    le_g = jnp.sum(le * jax.nn.one_hot(gsel[:, 0], MOE_GROUPS, dtype=jnp.float32)[:, :, None], axis=1)
    lv, li = lax.top_k(le_g, MOE_TOPK)
    w = jax.nn.softmax(lv, axis=-1) * ptop
    eid = gsel * MOE_PER_GROUP + li
    gates = jnp.sum(jax.nn.one_hot(eid, N_EXPERTS, dtype=jnp.float32) * w[..., None], axis=1)
    y = jnp.zeros(t.shape, jnp.float32)
    for e in range(N_EXPERTS):
        he = jax.nn.silu(t @ w_gate[e]) * (t @ w_up[e])
        y = y + gates[:, e:e + 1] * (he @ w_down[e]).astype(jnp.float32)
    return y.astype(h.dtype).reshape(Bn, L, D)


def setup_inputs(seed: int = 0) -> dict:
    key = jax.random.key(seed)
    ks = jax.random.split(key, 32)

    def nrm(k, shape, s):
        return jax.random.normal(k, shape, jnp.float32) * s

    D = D_MODEL
    return {
        'x': nrm(ks[0], (BATCH, SEQ, D), 1.0),
        'c': nrm(ks[1], (BATCH, D), 1.0),
        'ctx': nrm(ks[2], (BATCH, CTX_LEN, D), 1.0),
        'c_ctx': nrm(ks[3], (D,), 1.0),
        'w_ada': nrm(ks[4], (DEPTH, D, 6 * D), 0.2 * D ** -0.5),
        'b_ada': nrm(ks[5], (DEPTH, 6 * D), 0.01),
        'g_mix': 1.0 + nrm(ks[6], (DEPTH, D), 0.01),
        'w_in': nrm(ks[7], (DEPTH, D, D_IN), D ** -0.5),
        'sink': nrm(ks[8], (DEPTH, A_HEADS), 0.5),
        'ws_tok': nrm(ks[9], (DEPTH, B_GROUPS, B_CHUNK, B_CHUNK), B_CHUNK ** -0.5),
        'bs_tok': 1.0 + nrm(ks[10], (DEPTH, B_GROUPS, B_CHUNK), 0.02),
        'g_tok': 1.0 + nrm(ks[11], (DEPTH, B_GROUPS, B_DG), 0.01),
        'lam_q1': nrm(ks[12], (DEPTH, C_DQ), 0.1),
        'lam_k1': nrm(ks[13], (DEPTH, C_DQ), 0.1),
        'lam_q2': nrm(ks[14], (DEPTH, C_DQ), 0.1),
        'lam_k2': nrm(ks[15], (DEPTH, C_DQ), 0.1),
        'g_sub': 1.0 + nrm(ks[16], (DEPTH, C_DV), 0.01),
        'w_out': nrm(ks[17], (DEPTH, D_MIX, D), D_MIX ** -0.5),
        'g_ffn': 1.0 + nrm(ks[18], (DEPTH, D), 0.01),
        'w_rg': nrm(ks[19], (DEPTH, D, MOE_GROUPS), D ** -0.5),
        'b_rg': nrm(ks[20], (DEPTH, MOE_GROUPS), 0.01),
        'w_re': nrm(ks[21], (DEPTH, D, N_EXPERTS), D ** -0.5),
        'b_re': nrm(ks[22], (DEPTH, N_EXPERTS), 0.01),
        'w_gate': nrm(ks[23], (DEPTH, N_EXPERTS, D, D_EXPERT), D ** -0.5),
        'w_up': nrm(ks[24], (DEPTH, N_EXPERTS, D, D_EXPERT), D ** -0.5),
        'w_down': nrm(ks[25], (DEPTH, N_EXPERTS, D_EXPERT, D), D_EXPERT ** -0.5),
        'g_final': 1.0 + nrm(ks[26], (D,), 0.01),
    }


def reference(x, c, ctx, c_ctx, w_ada, b_ada, g_mix, w_in, sink, ws_tok, bs_tok, g_tok,
              lam_q1, lam_k1, lam_q2, lam_k2, g_sub, w_out, g_ffn, w_rg, b_rg, w_re, b_re,
              w_gate, w_up, w_down, g_final):
    S = x.shape[1]
    ROWS = S // GRID_W
    rows = jnp.repeat(jnp.arange(ROWS, dtype=jnp.float32), GRID_W)
    cols = jnp.broadcast_to(jnp.arange(GRID_W, dtype=jnp.float32)[None, :], (ROWS, GRID_W)).reshape(-1)
    xc = ctx
    for l in range(DEPTH):
        last = l == DEPTH - 1
        mod = jax.nn.silu(c) @ w_ada[l] + b_ada[l]
        modc = jax.nn.silu(c_ctx) @ w_ada[l] + b_ada[l]
        sh1, sc1, gt1, sh2, sc2, gt2 = jnp.split(mod[:, None, :], 6, axis=-1)
        csh1, csc1, cgt1, csh2, csc2, cgt2 = jnp.split(modc[None, None, :], 6, axis=-1)
        lam_init = 0.8 - 0.6 * math.exp(-0.3 * l)
        lam = (jnp.exp(jnp.sum(lam_q1[l].astype(jnp.float32) * lam_k1[l].astype(jnp.float32)))
               - jnp.exp(jnp.sum(lam_q2[l].astype(jnp.float32) * lam_k2[l].astype(jnp.float32))) + lam_init)
        h = rmsnorm(x, g_mix[l]) * (1.0 + sc1) + sh1
        hc = rmsnorm(xc, g_mix[l]) * (1.0 + csc1) + csh1
        y, y_c = token_mixers(h, hc, w_in[l], w_out[l], sink[l], ws_tok[l], bs_tok[l], g_tok[l],
                              g_sub[l], lam, lam_init, rows, cols, not last)
        x = x + gt1 * y
        h2 = rmsnorm(x, g_ffn[l]) * (1.0 + sc2) + sh2
        x = x + gt2 * hier_moe(h2, w_rg[l], b_rg[l], w_re[l], b_re[l], w_gate[l], w_up[l], w_down[l])
        if not last:
            xc = xc + cgt1 * y_c
            hc2 = rmsnorm(xc, g_ffn[l]) * (1.0 + csc2) + csh2
            xc = xc + cgt2 * hier_moe(hc2, w_rg[l], b_rg[l], w_re[l], b_re[l], w_gate[l], w_up[l], w_down[l])
    return rmsnorm(x, g_final)
```

```cpp
#include <hip/hip_runtime.h>
#include <cstdio>
#include <cstdint>
#ifndef PROBE_EPI2
#define PROBE_EPI2 0
#endif

#define LAS __attribute__((address_space(3)))
#define GAS __attribute__((address_space(1)))
typedef unsigned short bf16_t;
typedef unsigned short f16s_t;
typedef _Float16 f16x2_t __attribute__((ext_vector_type(2)));
typedef short bf16x8 __attribute__((ext_vector_type(8)));
typedef short s16x4 __attribute__((ext_vector_type(4)));
typedef float f32x4 __attribute__((ext_vector_type(4)));
typedef float f32x2 __attribute__((ext_vector_type(2)));
typedef float f32x16 __attribute__((ext_vector_type(16)));
typedef unsigned u32x4 __attribute__((ext_vector_type(4)));
typedef unsigned u32x2 __attribute__((ext_vector_type(2)));

typedef float f32x2_h __attribute__((ext_vector_type(2)));
__device__ __forceinline__ unsigned cvt_pk_f16(float lo, float hi) { f32x2_h v = {lo, hi}; f16x2_t h = __builtin_convertvector(v, f16x2_t); return __builtin_bit_cast(unsigned, h); }
__device__ __forceinline__ float hflo(unsigned w) { return (float)__builtin_bit_cast(f16x2_t, w)[0]; }
__device__ __forceinline__ float hfhi(unsigned w) { return (float)__builtin_bit_cast(f16x2_t, w)[1]; }

__device__ __forceinline__ int lane_id() { return (int)__builtin_amdgcn_mbcnt_hi(~0u, __builtin_amdgcn_mbcnt_lo(~0u, 0u)); }

namespace pg8 {
#define PG8_LAS __attribute__((address_space(3)))
constexpr int BM = 256, BK = 64, HALF = 128, HTB = HALF * BK * 2, STAGE_BYTES = 8 * HTB, NXCD = 8, WGM = 8;
__host__ __device__ __forceinline__ int lds_byte(int r, int c) { const int st = (r >> 4) * 2 + (c >> 5), rr = r & 15, cc = c & 31, ob = rr * 64 + cc * 2; return st * 1024 + (ob ^ (((ob >> 9) & 1) << 5)); }
__host__ __device__ __forceinline__ void stage_rc(int b, int& R, int& C) { const int st = b / 1024, sb = b % 1024, swz = sb ^ (((sb >> 9) & 1) << 5); R = (st >> 1) * 16 + swz / 64; C = (st & 1) * 32 + (swz % 64) / 2; }
__host__ __device__ __forceinline__ int perm32(int rho) { const int n = rho >> 4, i = rho & 15; return 8 * (i >> 2) + 4 * n + (i & 3); }

struct Unit { int pm, pn, be; };
struct Gemm { const bf16_t* A; const bf16_t* Bt; int M, N, K; size_t bstride; const PG8_LAS int* gmap; };

struct StaticOrder {
    int nM, nN, nwg, G, c;
    __host__ __device__ void init(int M, int N, int G_, int c_) { nM = M / BM; nN = N / BM; nwg = nM * nN; G = G_; c = c_; }
    __host__ __device__ bool next(int i, Unit& u) const {
        const long L = (long)i * G + c; if (L >= nwg) return false;
        int wgid = (int)L; { const int q = nwg / NXCD, r = nwg % NXCD, xcd = wgid % NXCD, off = wgid / NXCD; wgid = (xcd < r ? xcd * (q + 1) : r * (q + 1) + (xcd - r) * q) + off; }
        const int nig = WGM * nN, gid = wgid / nig, fm = gid * WGM, gsz = (nM - fm) < WGM ? (nM - fm) : WGM;
        u.pm = fm + ((wgid % nig) % gsz); u.pn = (wgid % nig) / gsz; u.be = 0; return true;
    }
    __device__ __forceinline__ void a_ready(const Unit&) const {}
    __device__ __forceinline__ void done(const Unit&) const {}
};
typedef __bf16 bf16x2_t __attribute__((ext_vector_type(2)));
__device__ __forceinline__ unsigned cvt_pk_bf16(float lo, float hi) { f32x2 v = {lo, hi}; bf16x2_t b = __builtin_convertvector(v, bf16x2_t); return __builtin_bit_cast(unsigned, b); }

template <class Epi, class Sched, bool ALIGN_EPI = false, bool SP2 = false, bool GATHER = false>
__device__ __forceinline__ void gemm_phase(PG8_LAS unsigned char* lds, const Gemm g, const Sched& S, const Epi& E, int wave_in) {
    int tid_l = wave_in * 64 + ::lane_id(); asm volatile("" : "+v"(tid_l));
    const int tid = tid_l, wid = __builtin_amdgcn_readfirstlane(tid >> 6), lane = tid & 63, wr = wid >> 2, wc = wid & 3, fr = lane & 15, fq = lane >> 4;
    const int K = g.K, nt = K / BK;
    unsigned voffA[2], voffB[2];
#pragma unroll
    for (int i = 0; i < 2; ++i) { int R, C; stage_rc(tid * 16 + i * 8192, R, C); const int Rb = Epi::PERM ? ((R & ~31) + perm32(R & 31)) : R;
        voffA[i] = (unsigned)(R * K + C) * 2u; voffB[i] = (unsigned)(Rb * K + C) * 2u; }
    const size_t kstep = (size_t)(BK * 2);
    const size_t hstep = (size_t)HALF * K * 2;
    const size_t tstep = GATHER ? 0 : 2 * hstep;
    const unsigned ldsw = (unsigned)wid * 1024u;
    const int aoff = lds_byte(wr * 64 + fr, fq * 8), boff = lds_byte(wc * 32 + fr, fq * 8);
#define PG8_SA(b, h) (((b) * 2 + (h)) * HTB)
#define PG8_SB(b, h) ((4 + (b) * 2 + (h)) * HTB)
#define PG8_STAGE(bufoff, gbase, voff) do { _Pragma("unroll") for (int _i = 0; _i < 2; ++_i) \
        __builtin_amdgcn_global_load_lds((const unsigned*)((const char*)(gbase) + (voff)[_i]), (PG8_LAS unsigned*)(lds + (bufoff) + ldsw + _i * 8192), 16, 0, 0); } while (0)
#define PG8_LDA(dst, b, h) do { _Pragma("unroll") for (int m = 0; m < 4; ++m) _Pragma("unroll") for (int k = 0; k < 2; ++k) dst[m][k] = *(const PG8_LAS bf16x8*)(lds + PG8_SA(b, h) + aoff + m * 2048 + k * 1024); } while (0)
#define PG8_LDB(dst, b, h) do { _Pragma("unroll") for (int n = 0; n < 2; ++n) _Pragma("unroll") for (int k = 0; k < 2; ++k) dst[n][k] = *(const PG8_LAS bf16x8*)(lds + PG8_SB(b, h) + boff + n * 2048 + k * 1024); } while (0)
#define PG8_MMA(ai, bj, At, Bt) do { __builtin_amdgcn_s_setprio(1); _Pragma("unroll") for (int m = 0; m < 4; ++m) _Pragma("unroll") for (int n = 0; n < 2; ++n) _Pragma("unroll") for (int k = 0; k < 2; ++k) \
        acc[ai][bj][m][n] = __builtin_amdgcn_mfma_f32_16x16x32_bf16(Bt[n][k], At[m][k], acc[ai][bj][m][n], 0, 0, 0); __builtin_amdgcn_s_setprio(0); } while (0)
#define PG8_WAIT_V(n) asm volatile("s_waitcnt vmcnt(" #n ")" ::: "memory")
#define PG8_WAIT_L(n) asm volatile("s_waitcnt lgkmcnt(" #n ")" ::: "memory")
#define PG8_BAR __builtin_amdgcn_s_barrier()
#define PG8_SCHED __builtin_amdgcn_sched_barrier(0)
    Unit cur, nxt; int ui = 0;
    if (!S.next(0, cur)) return;
    f32x4 acc[2][2][4][2];
#pragma unroll
    for (int a = 0; a < 2; ++a)
#pragma unroll
        for (int b = 0; b < 2; ++b)
#pragma unroll
            for (int m = 0; m < 4; ++m)
#pragma unroll
                for (int n = 0; n < 2; ++n) acc[a][b][m][n] = (f32x4){0.f, 0.f, 0.f, 0.f};
    bf16x8 At[4][2], B0[2][2], B1[2][2];
    unsigned vA0[2] = {0u, 0u}, vA1[2] = {0u, 0u}, nvA0[2] = {0u, 0u}, nvA1[2] = {0u, 0u};
#define PG8_GOFF(dst0, dst1, unit) do { _Pragma("unroll") for (int i_ = 0; i_ < 2; ++i_) { int R_, C_; stage_rc(tid * 16 + i_ * 8192, R_, C_); \
        const int m0_ = g.gmap[(unit) * 256 + R_], m1_ = g.gmap[(unit) * 256 + 128 + R_]; \
        dst0[i_] = (unsigned)((m0_ < 0 ? 0 : (m0_ >> 1)) * K + C_) * 2u; dst1[i_] = (unsigned)((m1_ < 0 ? 0 : (m1_ >> 1)) * K + C_) * 2u; } } while (0)
#define PG8_STAGE_A(bufoff, p, h, nx) do { if constexpr (GATHER) { unsigned tv_[2]; \
        tv_[0] = (nx) ? ((h) ? nvA1[0] : nvA0[0]) : ((h) ? vA1[0] : vA0[0]); tv_[1] = (nx) ? ((h) ? nvA1[1] : nvA0[1]) : ((h) ? vA1[1] : vA0[1]); PG8_STAGE(bufoff, p, tv_); } \
        else PG8_STAGE(bufoff, (p) + (h) * hstep, voffA); } while (0)
    const char* cA = (const char*)g.A + (size_t)cur.pm * tstep; const size_t btstep = 2 * (size_t)HALF * K * 2; const char* cB = (const char*)g.Bt + (size_t)cur.be * g.bstride + (size_t)cur.pn * btstep;
    S.a_ready(cur);
    if constexpr (GATHER) PG8_GOFF(vA0, vA1, 0);
    if constexpr (SP2) {
        PG8_STAGE(PG8_SB(0, 0), cB, voffB); PG8_STAGE(PG8_SB(0, 1), cB + hstep, voffB); PG8_STAGE_A(PG8_SA(0, 0), cA, 0, false); PG8_STAGE_A(PG8_SA(0, 1), cA, 1, false);
        if (wr == 1) PG8_BAR;
        PG8_WAIT_V(2); PG8_BAR;
        PG8_STAGE(PG8_SB(1, 0), cB + kstep, voffB); PG8_STAGE_A(PG8_SA(1, 0), cA + kstep, 0, false); PG8_STAGE(PG8_SB(1, 1), cB + hstep + kstep, voffB);
        PG8_WAIT_V(6); PG8_BAR;
    } else {
        PG8_STAGE(PG8_SB(0, 0), cB, voffB); PG8_STAGE(PG8_SA(0, 0), cA, voffA); PG8_STAGE(PG8_SB(0, 1), cB + hstep, voffB); PG8_STAGE(PG8_SA(0, 1), cA + hstep, voffA);
        if (wr == 1) PG8_BAR;
        PG8_WAIT_V(4); PG8_BAR;
        PG8_STAGE(PG8_SB(1, 0), cB + kstep, voffB); PG8_STAGE(PG8_SA(1, 0), cA + kstep, voffA); PG8_STAGE(PG8_SB(1, 1), cB + hstep + kstep, voffB);
        PG8_WAIT_V(6); PG8_BAR;
    }
    for (;;) {
        const bool has_next = S.next(ui + 1, nxt);
        const char* nA = has_next ? (const char*)g.A + (size_t)nxt.pm * tstep : cA; const char* nB = has_next ? (const char*)g.Bt + (size_t)nxt.be * g.bstride + (size_t)nxt.pn * btstep : cB;
        for (int t = 0; t < nt; t += 2) {
            const bool last = (t == nt - 2);
            const char* a1 = cA + (size_t)(t + 1) * kstep;
            const char* a2 = last ? nA : cA + (size_t)(t + 2) * kstep; const char* b2 = last ? nB : cB + (size_t)(t + 2) * kstep;
            const char* a3 = a2 + kstep; const char* b3 = b2 + kstep;
            if (last && has_next) S.a_ready(nxt);
            if constexpr (GATHER) { if (last) { const int un_ = has_next ? ui + 1 : ui; PG8_GOFF(nvA0, nvA1, un_); } }
            if constexpr (SP2) {
            PG8_LDB(B0, 0, 0); PG8_LDB(B1, 0, 1); PG8_SCHED; PG8_LDA(At, 0, 0); PG8_STAGE_A(PG8_SA(1, 1), a1, 1, false);
            PG8_WAIT_V(8); PG8_WAIT_L(0); PG8_BAR; PG8_MMA(0, 0, At, B0); PG8_MMA(0, 1, At, B1); PG8_BAR; PG8_SCHED;
            PG8_LDA(At, 0, 1); PG8_STAGE(PG8_SB(0, 0), b2, voffB); PG8_STAGE(PG8_SB(0, 1), b2 + hstep, voffB); PG8_STAGE_A(PG8_SA(0, 0), a2, 0, last);
            PG8_WAIT_V(8); PG8_WAIT_L(0); PG8_BAR; PG8_MMA(1, 0, At, B0); PG8_MMA(1, 1, At, B1); PG8_BAR; PG8_SCHED;
            PG8_LDB(B0, 1, 0); PG8_LDB(B1, 1, 1); PG8_SCHED; PG8_LDA(At, 1, 0); PG8_STAGE_A(PG8_SA(0, 1), a2, 1, last);
            PG8_WAIT_V(8); PG8_WAIT_L(0); PG8_BAR; PG8_MMA(0, 0, At, B0); PG8_MMA(0, 1, At, B1); PG8_BAR; PG8_SCHED;
            PG8_LDA(At, 1, 1); PG8_STAGE(PG8_SB(1, 0), b3, voffB); PG8_STAGE(PG8_SB(1, 1), b3 + hstep, voffB); PG8_STAGE_A(PG8_SA(1, 0), a3, 0, last);
            PG8_WAIT_V(8); PG8_WAIT_L(0); PG8_BAR; PG8_MMA(1, 0, At, B0); PG8_MMA(1, 1, At, B1); PG8_BAR; PG8_SCHED;
            } else {
            PG8_LDB(B0, 0, 0); PG8_SCHED; PG8_LDA(At, 0, 0); PG8_STAGE(PG8_SA(1, 1), a1 + hstep, voffA);
            PG8_WAIT_L(8); PG8_BAR; PG8_WAIT_L(0); PG8_MMA(0, 0, At, B0); PG8_BAR; PG8_SCHED;
            PG8_LDB(B1, 0, 1); PG8_STAGE(PG8_SB(0, 0), b2, voffB);
            PG8_BAR; PG8_WAIT_L(0); PG8_MMA(0, 1, At, B1); PG8_BAR;
            PG8_LDA(At, 0, 1); PG8_STAGE(PG8_SA(0, 0), a2, voffA);
            PG8_BAR; PG8_WAIT_L(0); PG8_MMA(1, 0, At, B0); PG8_BAR; PG8_SCHED;
            PG8_STAGE(PG8_SB(0, 1), b2 + hstep, voffB);
            PG8_WAIT_V(6); PG8_BAR; PG8_MMA(1, 1, At, B1); PG8_BAR;
            PG8_LDB(B0, 1, 0); PG8_SCHED; PG8_LDA(At, 1, 0); PG8_STAGE(PG8_SA(0, 1), a2 + hstep, voffA);
            PG8_WAIT_L(8); PG8_BAR; PG8_WAIT_L(0); PG8_MMA(0, 0, At, B0); PG8_BAR; PG8_SCHED;
            PG8_LDB(B1, 1, 1); PG8_STAGE(PG8_SB(1, 0), b3, voffB);
            PG8_BAR; PG8_WAIT_L(0); PG8_MMA(0, 1, At, B1); PG8_BAR;
            PG8_LDA(At, 1, 1); PG8_STAGE(PG8_SA(1, 0), a3, voffA);
            PG8_BAR; PG8_WAIT_L(0); PG8_MMA(1, 0, At, B0); PG8_BAR; PG8_SCHED;
            PG8_STAGE(PG8_SB(1, 1), b3 + hstep, voffB);
            PG8_WAIT_V(6); PG8_BAR; PG8_MMA(1, 1, At, B1); PG8_BAR;
            }
        }
        if constexpr (ALIGN_EPI) { if (wr == 0) PG8_BAR; }
#if PROBE_EPI2
        if constexpr (!Epi::AFTER_DRAIN) {
            int nrep_ = 1; if constexpr (Epi::IDEM) { if (E.can_repeat()) nrep_ = 2; } asm volatile("" : "+s"(nrep_));
            for (int rep_ = 0; rep_ < nrep_; ++rep_) { asm volatile("" ::: "memory");
                _Pragma("unroll") for (int a = 0; a < 2; ++a) _Pragma("unroll") for (int b = 0; b < 2; ++b) _Pragma("unroll") for (int m = 0; m < 4; ++m) _Pragma("unroll") for (int n = 0; n < 2; ++n) asm volatile("" : "+v"(acc[a][b][m][n]));
                E(acc, cur, wr, wc, fr, fq); }
            S.done(cur); }
#else
        if constexpr (!Epi::AFTER_DRAIN) { E(acc, cur, wr, wc, fr, fq); S.done(cur); }
#endif
        if (!has_next) break;
#pragma unroll
        for (int a = 0; a < 2; ++a)
#pragma unroll
            for (int b = 0; b < 2; ++b)
#pragma unroll
                for (int m = 0; m < 4; ++m)
#pragma unroll
                    for (int n = 0; n < 2; ++n) acc[a][b][m][n] = (f32x4){0.f, 0.f, 0.f, 0.f};
        cur = nxt; cA = nA; cB = nB; ++ui;
        if constexpr (GATHER) { vA0[0] = nvA0[0]; vA0[1] = nvA0[1]; vA1[0] = nvA1[0]; vA1[1] = nvA1[1]; }
        if constexpr (ALIGN_EPI) { if (wr == 1) PG8_BAR; }
    }
    PG8_WAIT_V(0);
    if constexpr (!ALIGN_EPI) { if (wr == 0) PG8_BAR; }
    PG8_BAR;
    if constexpr (Epi::AFTER_DRAIN) { E.fused(acc, cur, wr, wc, fr, fq, lds, wid, lane); S.done(cur); }
#undef PG8_GOFF
#undef PG8_STAGE_A
#undef PG8_SA
#undef PG8_SB
#undef PG8_STAGE
#undef PG8_LDA
#undef PG8_LDB
#undef PG8_MMA
#undef PG8_WAIT_V
#undef PG8_WAIT_L
#undef PG8_BAR
#undef PG8_SCHED
}
}

constexpr int D = 1024, SEQ = 16384, CTX = 256, NB = 2;
constexpr int NLAT = NB * SEQ, NCTX = NB * CTX, NROW = NLAT + NCTX;
constexpr int KEYS = CTX + SEQ;
constexpr int DIN = 2048, NEXP = 16, DEXP = 512, MOE_ROWS = 70656;
constexpr float EPS = 1e-6f, LOG2E = 1.4426950408889634f, NEGBIG = -1e30f;
constexpr int NWAVES = 8, NTHR = 512, CTXP_WGS = 16;
constexpr int N_PHASES = 18;

constexpr size_t MiB = 1u << 20;
constexpr size_t WS_CTL = 0, CTL_ZERO_BYTES = 1 * MiB;
constexpr size_t WS_MOD = 1 * MiB;
constexpr size_t WS_TABA = WS_MOD + 160 * 1024;
constexpr size_t WS_TABC = WS_TABA + 32 * 1024;
constexpr size_t WS_WSTOK = 1 * MiB + 256 * 1024;
constexpr size_t WS_HIST = 1 * MiB + 512 * 1024;
constexpr size_t WS_CNT = WS_HIST + 64 * 1024;
constexpr size_t WS_ROUTE = 2 * MiB;
constexpr size_t WS_ROWMAP = 3 * MiB;
constexpr size_t WS_WSLOT = 3 * MiB + 320 * 1024;
constexpr size_t WS_WIN = 4 * MiB, WS_WOUT = 12 * MiB, WS_WGU = 16 * MiB, WS_WD = 80 * MiB;
constexpr size_t WS_R1 = 112 * MiB, WS_R2 = 315 * MiB, WS_XS = 445 * MiB, WS_END = 510 * MiB;
constexpr size_t R1_QA = 0, R1_KA = 34078720, R1_VA = 42598400, R1_QC = 51118080, R1_KC = 68157440, R1_VC = 85196800, R1_BU = 102236160, R1_BV = 119275520;
constexpr size_t R1_H = 130 * MiB, R1_H2 = 138 * MiB, R1_HE = 0;
static_assert(R1_BV + (size_t)NROW * 256 * 2 == 130 * MiB && (size_t)MOE_ROWS * D * 2 == 138 * MiB && WS_R1 + 203 * MiB == WS_R2 && R1_H2 + (size_t)NROW * D * 2 == 203 * MiB && WS_R2 + (size_t)2 * NROW * D * 2 == WS_XS && WS_XS + (size_t)NROW * D * 2 == WS_END, "ws map");
constexpr int CW_TMO = 0, CW_BAR = 4096, CW_BND = 8192, CW_MIXQ = 9216, CW_MOEC = 32768;

constexpr int RING_BYTES = 131072, MISC_OFF = RING_BYTES + 320, TBL_OFF = RING_BYTES + 1024, GMAP_OFF = TBL_OFF + 128, GMAP_UNITS = 8, LDS_BYTES = 147456;
static_assert(GMAP_OFF + GMAP_UNITS * 1024 <= LDS_BYTES, "lds map");

#define RLX_AGENT __ATOMIC_RELAXED, __HIP_MEMORY_SCOPE_AGENT
__device__ __forceinline__ unsigned f2bf(float f) { unsigned u = __builtin_bit_cast(unsigned, f); return (u + 0x7fffu + ((u >> 16) & 1u)) >> 16; }
__device__ __forceinline__ unsigned pk2(float lo, float hi) { return pg8::cvt_pk_bf16(lo, hi); }
__device__ __forceinline__ float bf2f(unsigned short h) { return __builtin_bit_cast(float, (unsigned)h << 16); }
__device__ __forceinline__ float bflo(unsigned w) { return __builtin_bit_cast(float, w << 16); }
__device__ __forceinline__ float bfhi(unsigned w) { return __builtin_bit_cast(float, w & 0xffff0000u); }
template <int CTRL> __device__ __forceinline__ float dpp_xadd(float v) { return v + __uint_as_float(__builtin_amdgcn_update_dpp(0u, __float_as_uint(v), CTRL, 0xf, 0xf, false)); }
__device__ __forceinline__ float row16_sum(float v) {
    v = dpp_xadd<0xB1>(v); v = dpp_xadd<0x4E>(v); v = dpp_xadd<0x141>(v); v = dpp_xadd<0x140>(v); return v; }
__device__ __forceinline__ float swap16_add(float a, float b) { auto r = __builtin_amdgcn_permlane16_swap(__float_as_uint(a), __float_as_uint(b), false, false); return __uint_as_float(r[0]) + __uint_as_float(r[1]); }
__device__ __forceinline__ float swap32_add(float a, float b) { auto r = __builtin_amdgcn_permlane32_swap(__float_as_uint(a), __float_as_uint(b), false, false); return __uint_as_float(r[0]) + __uint_as_float(r[1]); }
__device__ __forceinline__ float xor32_sum(float v) { return swap32_add(v, v); }
__device__ __forceinline__ float wave_sum(float v) { v = row16_sum(v); v = swap16_add(v, v); return swap32_add(v, v); }
__device__ __forceinline__ float silu_f(float x) { return x * __builtin_amdgcn_rcpf(1.f + __expf(-x)); }
__device__ __forceinline__ float gelu_tanh(float x) { const float z = 0.7978845608028654f * (x + 0.044715f * x * x * x); return x * __builtin_amdgcn_rcpf(1.f + __expf(-2.f * z)); }

#define XB_TMO      128
#define XB_XCNT(j)  (256  + 64 * (j))
#define XB_XSUB(j)  (1280 + 64 * (j))
#define XB_XGEN(j)  (2304 + 64 * (j))
#define XB_TOP      3328
#define XB_TOPGEN   3392
#define XCD_BAR_WORDS 3456
#define XB_SPIN_CAP (1u << 22)
__device__ __forceinline__ unsigned xb_ld(unsigned* p)              { return __hip_atomic_load(p, __ATOMIC_RELAXED, __HIP_MEMORY_SCOPE_AGENT); }
__device__ __forceinline__ unsigned xb_add(unsigned* p, unsigned v) { return __hip_atomic_fetch_add(p, v, __ATOMIC_RELAXED, __HIP_MEMORY_SCOPE_AGENT); }
__device__ __forceinline__ unsigned xb_xcc_id() { return (unsigned)__builtin_amdgcn_s_getreg((3 << 11) | 20) & 0xFu; }
#define XB_SPIN(cond, bar) do { unsigned _sp = 0; while (cond) { __builtin_amdgcn_s_sleep(1); \
    if ((++_sp & 255u) == 0u) { if (xb_ld(&(bar)[XB_TMO])) break; if (_sp > XB_SPIN_CAP) { atomicAdd(&(bar)[XB_TMO], 1u); break; } } } } while (0)
struct XcdBarrier { unsigned* bar; unsigned x; volatile LAS unsigned* st; };
__device__ __forceinline__ XcdBarrier xcd_barrier_post(unsigned* bar, volatile LAS unsigned* st, int wave) {
    XcdBarrier b; b.bar = bar; b.x = xb_xcc_id(); b.st = st;
    if (wave == 0 && lane_id() == 0) (void)xb_add(&bar[XB_XCNT(b.x)], 1u);
    return b;
}
__device__ __forceinline__ void xcd_barrier_complete(unsigned* bar, unsigned x, unsigned& nloc, unsigned& nx) {
    const unsigned G = gridDim.x * gridDim.y * gridDim.z;
    unsigned sum, cnt, mine, sp = 0u;
    for (;;) {
        sum = 0u; cnt = 0u; mine = 0u;
#pragma unroll
        for (unsigned j = 0; j < 16; ++j) { const unsigned c = xb_ld(&bar[XB_XCNT(j)]); sum += c; cnt += (c > 0u) ? 1u : 0u; mine = (j == x) ? c : mine; }
        if (sum == G) break;
        __builtin_amdgcn_s_sleep(1);
        if ((++sp & 255u) == 0u) { if (xb_ld(&bar[XB_TMO])) break; if (sp > XB_SPIN_CAP) { atomicAdd(&bar[XB_TMO], 1u); break; } }
    }
    nloc = mine > 0u ? mine : 1u; nx = cnt > 0u ? cnt : 1u;
}
__device__ __forceinline__ void xcd_barrier(const XcdBarrier& b, int wave) {
    asm volatile("s_waitcnt vmcnt(0)" ::: "memory");
    __syncthreads();
    if (wave == 0 && lane_id() == 0) {
        unsigned* bar = b.bar;
        __builtin_amdgcn_s_waitcnt(0);
        unsigned nloc = b.st[0], nx = b.st[1];
        if (nloc == 0u) { xcd_barrier_complete(bar, b.x, nloc, nx); b.st[0] = nloc; b.st[1] = nx; }
        const unsigned old = xb_add(&bar[XB_XSUB(b.x)], 1u);
        const unsigned gen = old / nloc;
        if (old + 1u == (gen + 1u) * nloc) {
            __builtin_amdgcn_fence(__ATOMIC_RELEASE, "agent");
            asm volatile("s_waitcnt vmcnt(0)" ::: "memory");
            const unsigned og = xb_add(&bar[XB_TOP], 1u);
            const unsigned tg = og / nx;
            if (og + 1u == (tg + 1u) * nx) xb_add(&bar[XB_TOPGEN], 1u);
            else XB_SPIN(xb_ld(&bar[XB_TOPGEN]) == tg, bar);
            __builtin_amdgcn_fence(__ATOMIC_ACQUIRE, "agent");
            xb_add(&bar[XB_XGEN(b.x)], 1u);
            asm volatile("s_waitcnt vmcnt(0)" ::: "memory");
        } else {
            XB_SPIN(xb_ld(&bar[XB_XGEN(b.x)]) == gen, bar);
            __builtin_amdgcn_fence(__ATOMIC_ACQUIRE, "agent");
            asm volatile("s_waitcnt vmcnt(0)" ::: "memory");
        }
    }
    __syncthreads();
}

struct Frame {
    LAS unsigned char* lds;
    int tid, wave, G, bid;
    float* out; unsigned char* ws;
};
#define INP(i) ((const float*)((const GAS float* const __attribute__((address_space(4)))*)__builtin_amdgcn_kernarg_segment_ptr())[i])
enum { I_X = 0, I_C, I_CTX, I_CCTX, I_WADA, I_BADA, I_GMIX, I_WIN, I_SINK, I_WSTOK, I_BSTOK, I_GTOK, I_LQ1, I_LK1, I_LQ2, I_LK2, I_GSUB, I_WOUT, I_GFFN, I_WRG, I_BRG, I_WRE, I_BRE, I_WGATE, I_WUP, I_WDOWN, I_GFINAL };

__device__ __forceinline__ bf16_t* xs_row(const Frame& F, int r) { return (bf16_t*)(F.ws + WS_XS) + (size_t)r * D; }
__device__ __forceinline__ const float* xin_row(const Frame& F, int r) { return r < NLAT ? INP(I_X) + (size_t)r * D : INP(I_CTX) + (size_t)(r - NLAT) * D; }
__device__ __forceinline__ int mod_w(int r) { return r < NLAT ? (r >> 14) : 2; }
__device__ __forceinline__ const float* mod_ptr(const Frame& F, int l, int w, int chunk) { return (const float*)(F.ws + WS_MOD) + ((size_t)(l * 3 + w) * 6 + chunk) * D; }

__device__ __forceinline__ int rope_perm(int j, int ptype) {
    if (ptype == 1) return (j >> 1) + 16 * (j & 1);
    if (ptype == 2) return j < 16 ? (j >> 1) + 8 * (j & 1) : 16 + ((j - 16) >> 1) + 8 * (j & 1);
    return j;
}
struct P0Item { const float* src; bf16_t* dst; int K, N, ptype; };
constexpr int IT_IN = 2 * 16 * 64, IT_OUT = 2 * 16 * 32, IT_G = 32 * 256, IT_U = 32 * 256, IT_D = 32 * 256;
constexpr int P0_NITEMS = IT_IN + IT_OUT + IT_G + IT_U + IT_D;
#ifndef P0_DEFER
#define P0_DEFER 0
#endif
constexpr int P0_EARLY = P0_DEFER ? IT_IN / 2 : P0_NITEMS;
constexpr int CV_PER_UNIT = 64;
constexpr int CV_UNITS = (P0_NITEMS - P0_EARLY) / CV_PER_UNIT;
static_assert((P0_NITEMS - P0_EARLY) % CV_PER_UNIT == 0, "conversion units");
__device__ __forceinline__ P0Item p0_decode(const Frame& F, int it) {
    P0Item q; int r = it;
    if (r < IT_IN) { const int l = r >> 10, x = r & 1023, kb = x >> 6, nb = x & 63, n0 = nb * 32;
        q.ptype = n0 < 640 ? 1 : ((n0 >= 1280 && n0 < 1792) ? 2 : 0); q.K = D; q.N = DIN;
        q.src = INP(I_WIN) + (size_t)l * D * DIN + (size_t)(kb * 64) * DIN + n0; q.dst = (bf16_t*)(F.ws + WS_WIN) + ((size_t)l * DIN + n0) * D + kb * 64; return q; }
    r -= IT_IN;
    if (r < IT_OUT) { const int l = r >> 9, x = r & 511, kb = x >> 5, nb = x & 31, n0 = nb * 32;
        q.ptype = 0; q.K = D; q.N = D;
        q.src = INP(I_WOUT) + (size_t)l * D * D + (size_t)(kb * 64) * D + n0; q.dst = (bf16_t*)(F.ws + WS_WOUT) + ((size_t)l * D + n0) * D + kb * 64; return q; }
    r -= IT_OUT;
    if (r < IT_G + IT_U) { const int up = r >= IT_G; if (up) r -= IT_G; const int idx = r >> 8, x = r & 255, kb = x >> 4, nb = x & 15, n0 = nb * 32;
        const int drow = (n0 >> 7) * 256 + (n0 & 127) + (up ? 128 : 0);
        q.ptype = 0; q.K = D; q.N = DEXP;
        q.src = (up ? INP(I_WUP) : INP(I_WGATE)) + (size_t)idx * D * DEXP + (size_t)(kb * 64) * DEXP + n0; q.dst = (bf16_t*)(F.ws + WS_WGU) + ((size_t)idx * 1024 + drow) * D + kb * 64; return q; }
    r -= IT_G + IT_U;
    { const int idx = r >> 8, x = r & 255, kb = x >> 5, nb = x & 31, n0 = nb * 32;
        q.ptype = 0; q.K = DEXP; q.N = D;
        q.src = INP(I_WDOWN) + (size_t)idx * DEXP * D + (size_t)(kb * 64) * D + n0; q.dst = (bf16_t*)(F.ws + WS_WD) + ((size_t)idx * D + n0) * DEXP + kb * 64; return q; }
}
__device__ __forceinline__ void p0_load(const P0Item& q, float (&v)[32], int lane) {
#pragma unroll
    for (int i = 0; i < 32; ++i) v[i] = q.src[(size_t)(2 * i + (lane >> 5)) * q.N + (lane & 31)];
}
__device__ __forceinline__ void p0_lds_write(const float (&v)[32], LAS float* scr, int lane) {
#pragma unroll
    for (int i = 0; i < 32; ++i) scr[(2 * i + (lane >> 5)) * 33 + (lane & 31)] = v[i];
}
__device__ __forceinline__ void p0_finish(const P0Item& q, LAS float* scr, int lane) {
    asm volatile("s_waitcnt lgkmcnt(0)" ::: "memory");
    const int c = lane & 7;
#pragma unroll
    for (int j = 0; j < 4; ++j) { const int n = (lane >> 3) + 8 * j; const LAS float* s = scr + (8 * c) * 33 + rope_perm(n, q.ptype);
        u32x4 o; o.x = pk2(s[0 * 33], s[1 * 33]); o.y = pk2(s[2 * 33], s[3 * 33]); o.z = pk2(s[4 * 33], s[5 * 33]); o.w = pk2(s[6 * 33], s[7 * 33]);
        *(u32x4*)(q.dst + (size_t)n * q.K + 8 * c) = o; }
    asm volatile("s_waitcnt lgkmcnt(0)" ::: "memory");
}
__device__ __forceinline__ void p0_items(const Frame& F, int it0, int stride, int n, LAS float* scr, int lane) {
    if (n <= 0) return;
    float v[32];
    P0Item cur = p0_decode(F, it0);
    p0_load(cur, v, lane);
    for (int j = 0; j < n; ++j) {
        p0_lds_write(v, scr, lane);
        P0Item nxt = cur;
        if (j + 1 < n) { nxt = p0_decode(F, it0 + (j + 1) * stride); p0_load(nxt, v, lane); }
        p0_finish(cur, scr, lane);
        cur = nxt;
    }
}
__device__ __forceinline__ void p0_prologue(Frame& F) {
    LAS float* scr = (LAS float*)(F.lds + F.wave * 16384);
    { const int gwr = (F.G - 1 - F.bid) * NWAVES + F.wave, NGW = F.G * NWAVES;
      p0_items(F, gwr, NGW, gwr < P0_EARLY ? (P0_EARLY - gwr + NGW - 1) / NGW : 0, scr, (F.tid & 63)); }
    __syncthreads();
    for (int it = F.bid; it < 2 * 96; it += F.G) {
        const int l = it / 96, n = (it % 96) * 64 + (F.tid & 63);
        const float* wa = INP(I_WADA) + (size_t)l * D * 6144 + n;
        const int kb = F.wave * 128;
        float s0[2], s1[2], s2[2];
#pragma unroll
        for (int h = 0; h < 2; ++h) { s0[h] = silu_f(INP(I_C)[kb + 64 * h + (F.tid & 63)]); s1[h] = silu_f(INP(I_C)[D + kb + 64 * h + (F.tid & 63)]); s2[h] = silu_f(INP(I_CCTX)[kb + 64 * h + (F.tid & 63)]); }
        float a0 = 0.f, a1 = 0.f, a2 = 0.f;
#pragma unroll
        for (int kk = 0; kk < 2; ++kk) { float w[64];
#pragma unroll
            for (int i = 0; i < 64; ++i) w[i] = wa[(size_t)(kb + kk * 64 + i) * 6144];
            __builtin_amdgcn_sched_barrier(0);
#pragma unroll
            for (int i = 0; i < 64; ++i) {
                a0 += __int_as_float(__builtin_amdgcn_readlane(__float_as_int(s0[kk]), i)) * w[i];
                a1 += __int_as_float(__builtin_amdgcn_readlane(__float_as_int(s1[kk]), i)) * w[i];
                a2 += __int_as_float(__builtin_amdgcn_readlane(__float_as_int(s2[kk]), i)) * w[i]; } }
        LAS float* part = (LAS float*)(F.lds + F.wave * 16384 + 12288);
        part[(F.tid & 63)] = a0; part[64 + (F.tid & 63)] = a1; part[128 + (F.tid & 63)] = a2;
        __syncthreads();
        if (F.wave < 3) { float s = INP(I_BADA)[l * 6144 + n];
#pragma unroll
            for (int w = 0; w < 8; ++w) s += ((LAS float*)(F.lds + w * 16384 + 12288))[F.wave * 64 + (F.tid & 63)];
            ((float*)(F.ws + WS_MOD))[(size_t)(l * 3 + F.wave) * 6144 + n] = s; }
        __syncthreads();
    }
    const int gt = F.bid * NTHR + F.tid, NGT = F.G * NTHR;
    for (int i = gt; i < 256 * 16 + 256 * 8; i += NGT) {
        if (i < 4096) { const int pos = i >> 4, j = i & 15; const double ang = (double)pos * pow(10000.0, -(double)j / 16.0);
            ((f32x2*)(F.ws + WS_TABA))[i] = (f32x2){(float)cos(ang), (float)sin(ang)}; }
        else { const int q = i - 4096, pos = q >> 3, j = q & 7; const double ang = (double)pos * pow(10000.0, -(double)j / 8.0);
            ((f32x2*)(F.ws + WS_TABC))[q] = (f32x2){(float)cos(ang), (float)sin(ang)}; }
    }
    for (int i = gt; i < 2 * 4 * 128 * 128; i += NGT) ((bf16_t*)(F.ws + WS_WSTOK))[i] = (bf16_t)f2bf(INP(I_WSTOK)[i]);
}

template <int MODE>
__device__ __forceinline__ void norm_phase(Frame& F, int l) {
    const int gw = F.bid * NWAVES + F.wave, NGW = F.G * NWAVES;
    bf16_t* H = (bf16_t*)(F.ws + WS_R1 + R1_H);
    const bf16_t* YE = (const bf16_t*)(F.ws + WS_R2);
    const int lp = (MODE == 2) ? 1 : 0, M = (MODE == 2) ? NLAT : NROW;
    int wcur = -1; f32x4 A[4], B[4], G[4], GF[4];
    if (MODE == 2) { const f32x4* g = (const f32x4*)INP(I_GFINAL) + (F.tid & 63);
#pragma unroll
        for (int j = 0; j < 4; ++j) GF[j] = g[64 * j]; }
    for (int rb = gw * 4; rb < M; rb += NGW * 4) {
        const int w = mod_w(rb);
        if (w != wcur) { wcur = w;
            if (MODE != 0) { const f32x4* gt2 = (const f32x4*)mod_ptr(F, lp, w, 5) + (F.tid & 63);
#pragma unroll
                for (int j = 0; j < 4; ++j) G[j] = gt2[64 * j]; }
            if (MODE != 2) { const f32x4* g = (const f32x4*)(INP(I_GMIX) + l * D) + (F.tid & 63); const f32x4* sh = (const f32x4*)mod_ptr(F, l, w, 0) + (F.tid & 63); const f32x4* sc = (const f32x4*)mod_ptr(F, l, w, 1) + (F.tid & 63);
#pragma unroll
                for (int j = 0; j < 4; ++j) { A[j] = g[64 * j] * (1.f + sc[64 * j]); B[j] = sh[64 * j]; } } }
        f32x4 v[4][4];
        if (MODE == 0) {
#pragma unroll
            for (int t = 0; t < 4; ++t) { const f32x4* s = (const f32x4*)xin_row(F, rb + t) + (F.tid & 63);
#pragma unroll
                for (int j = 0; j < 4; ++j) v[t][j] = s[64 * j]; }
        } else {
            u32x2 ya[4][4], yb[4][4], xq[4][4];
#pragma unroll
            for (int t = 0; t < 4; ++t) { const int r = rb + t; const u32x2* s = (const u32x2*)xs_row(F, r) + (F.tid & 63);
                const u32x2* y0 = (const u32x2*)(YE + (size_t)(2 * r) * D) + (F.tid & 63); const u32x2* y1 = (const u32x2*)(YE + (size_t)(2 * r + 1) * D) + (F.tid & 63);
#pragma unroll
                for (int j = 0; j < 4; ++j) { xq[t][j] = s[64 * j]; ya[t][j] = y0[64 * j]; yb[t][j] = y1[64 * j]; } }
#pragma unroll
            for (int t = 0; t < 4; ++t) { const int r = rb + t;
#pragma unroll
                for (int j = 0; j < 4; ++j) { const u32x2 a = ya[t][j], b = yb[t][j], x = xq[t][j];
                    f32x4 y; y.x = bflo(a.x) + bflo(b.x); y.y = bfhi(a.x) + bfhi(b.x); y.z = bflo(a.y) + bflo(b.y); y.w = bfhi(a.y) + bfhi(b.y);
                    v[t][j] = (f32x4){hflo(x.x), hfhi(x.x), hflo(x.y), hfhi(x.y)} + G[j] * y; }
                if (MODE == 1) { bf16_t* xr = xs_row(F, r);
#pragma unroll
                    for (int j = 0; j < 4; ++j) ((u32x2*)xr + (F.tid & 63))[64 * j] = (u32x2){cvt_pk_f16(v[t][j].x, v[t][j].y), cvt_pk_f16(v[t][j].z, v[t][j].w)}; } }
        }
        float ss[4];
#pragma unroll
        for (int t = 0; t < 4; ++t) { float s = 0.f;
#pragma unroll
            for (int j = 0; j < 4; ++j) s += (v[t][j].x * v[t][j].x + v[t][j].y * v[t][j].y) + (v[t][j].z * v[t][j].z + v[t][j].w * v[t][j].w);
            ss[t] = s; }
#pragma unroll
        for (int t = 0; t < 4; ++t) ss[t] = wave_sum(ss[t]);
#pragma unroll
        for (int t = 0; t < 4; ++t) { const int r = rb + t; const float rinv = 1.0f / sqrtf(ss[t] * (1.f / D) + EPS);
            if (MODE == 2) { f32x4* o = (f32x4*)(F.out + (size_t)r * D) + (F.tid & 63);
#pragma unroll
                for (int j = 0; j < 4; ++j) o[64 * j] = v[t][j] * (GF[j] * rinv); }
            else { u32x2* o = (u32x2*)(H + (size_t)r * D) + (F.tid & 63);
#pragma unroll
                for (int j = 0; j < 4; ++j) { const f32x4 h = v[t][j] * (A[j] * rinv) + B[j]; o[64 * j] = (u32x2){pk2(h.x, h.y), pk2(h.z, h.w)}; } } }
    }
}

typedef const f32x4 (&AccRef)[2][2][4][2];

__device__ __forceinline__ void st_wt16(void* p, u32x4 v) { asm volatile("global_store_dwordx4 %0, %1, off sc0 sc1\n\ts_nop 1" :: "v"((GAS void*)p), "v"(v) : "memory"); }
#ifndef PROBE_ST2
#define PROBE_ST2 0
#endif
#ifndef EPIPROJ_WT
#define EPIPROJ_WT 0
#endif
struct EpiProj {
    static constexpr bool PERM = true, AFTER_DRAIN = false, IDEM = true;
    __device__ __forceinline__ bool can_repeat() const { return true; }
    unsigned char* r1; const f32x2* tabA; const f32x2* tabC; unsigned* bnd;
    static __device__ __forceinline__ void rot4(f32x4& v0, f32x4& v1, const f32x2* tb, float sc) {
        const f32x4 t0 = *(const f32x4*)tb, t1 = *(const f32x4*)(tb + 2);
        f32x4 a, b;
        a.x = v0.x * t0.x - v0.y * t0.y; a.y = v0.x * t0.y + v0.y * t0.x; a.z = v0.z * t0.z - v0.w * t0.w; a.w = v0.z * t0.w + v0.w * t0.z;
        b.x = v1.x * t1.x - v1.y * t1.y; b.y = v1.x * t1.y + v1.y * t1.x; b.z = v1.z * t1.z - v1.w * t1.w; b.w = v1.z * t1.w + v1.w * t1.z;
        v0 = a * sc; v1 = b * sc;
    }
    static __device__ __forceinline__ void rot4r(f32x4& v0, f32x4& v1, const f32x4 t0, const f32x4 t1, float sc) {
        f32x4 a, b;
        a.x = v0.x * t0.x - v0.y * t0.y; a.y = v0.x * t0.y + v0.y * t0.x; a.z = v0.z * t0.z - v0.w * t0.w; a.w = v0.z * t0.w + v0.w * t0.z;
        b.x = v1.x * t1.x - v1.y * t1.y; b.y = v1.x * t1.y + v1.y * t1.x; b.z = v1.z * t1.z - v1.w * t1.w; b.w = v1.z * t1.w + v1.w * t1.z;
        v0 = a * sc; v1 = b * sc;
    }
    template <int KIND, int RS>
    static __device__ __forceinline__ void run(AccRef acc, bf16_t* base0, bf16_t* base1, const f32x4 (&T0)[4], const f32x4 (&T1)[4], bool usep, float sc, unsigned* w0, unsigned* w1) {
        float mxv[2] = {0.f, 0.f};
#pragma unroll
        for (int ai = 0; ai < 2; ++ai) {
            float sq[2][4];
#pragma unroll
            for (int m = 0; m < 4; ++m) {
                f32x4 t0 = T0[0], t1 = T1[0];
                if (KIND != 2) {
#pragma unroll
                    for (int e = 0; e < 4; ++e) { t0[e] = usep ? T0[ai][e] : T0[m][e]; t1[e] = usep ? T1[ai][e] : T1[m][e]; } }
#pragma unroll
                for (int bj = 0; bj < 2; ++bj) {
                    const bool rot = KIND == 0 || (KIND == 1 && bj == 0);
                    f32x4 v0 = acc[ai][bj][m][0], v1 = acc[ai][bj][m][1];
                    if (rot) rot4r(v0, v1, t0, t1, sc);
                    u32x4 w; w.x = pg8::cvt_pk_bf16(v0.x, v0.y); w.y = pg8::cvt_pk_bf16(v0.z, v0.w); w.z = pg8::cvt_pk_bf16(v1.x, v1.y); w.w = pg8::cvt_pk_bf16(v1.z, v1.w);
                    if (EPIPROJ_WT) st_wt16((bj ? base1 : base0) + (size_t)(ai * 128 + m * 16) * RS, w); else *(u32x4*)((bj ? base1 : base0) + (size_t)(ai * 128 + m * 16) * RS) = w;
#if PROBE_ST2
                    asm volatile("" : "+v"(w) :: "memory"); *(u32x4*)((bj ? base1 : base0) + (size_t)(ai * 128 + m * 16) * RS) = w;
#endif
                    if (rot) sq[bj][m] = (v0.x * v0.x + v0.y * v0.y) + (v0.z * v0.z + v0.w * v0.w) + (v1.x * v1.x + v1.y * v1.y) + (v1.z * v1.z + v1.w * v1.w);
                }
                __builtin_amdgcn_sched_barrier(0);
            }
#pragma unroll
            for (int bj = 0; bj < 2; ++bj) if (KIND == 0 || (KIND == 1 && bj == 0))
                mxv[bj] = fmaxf(mxv[bj], swap32_add(swap16_add(sq[bj][0], sq[bj][1]), swap16_add(sq[bj][2], sq[bj][3])));
            __builtin_amdgcn_sched_barrier(0);
        }
#pragma unroll
        for (int bj = 0; bj < 2; ++bj) if (KIND == 0 || (KIND == 1 && bj == 0)) {
            float mw = mxv[bj];
#pragma unroll
            for (int o = 1; o < 64; o <<= 1) mw = fmaxf(mw, __shfl_xor(mw, o));
            if (lane_id() == 0) atomicMax(bj ? w1 : w0, __float_as_uint(mw)); }
    }
    __device__ __forceinline__ void operator()(AccRef acc, const pg8::Unit& u, int wr, int wc, int fr_in, int fq_in) const {
        int fr = fr_in, fq = fq_in; asm volatile("" : "+v"(fr), "+v"(fq));
        const int pn = u.pn, b = u.pm >> 6, tl0 = (u.pm & 63) * 256, hw = wc >> 1, wl = wc & 1;
        constexpr float QSA = 0.125f * LOG2E, QSC = 0.17677669529663687f * LOG2E;
        const int pos0 = CTX + tl0 + wr * 64 + fr, dc = wl * 32 + fq * 8;
        const bool ropeA = pn <= 2, ropeC = (pn == 5) || (pn == 6);
        const bool usep = ropeA ? (wl == 0) : (fq < 2);
        f32x4 T0[4], T1[4];
        { const f32x2* tb = ropeA ? tabA : tabC; const int strd = ropeA ? 16 : 8, col = ropeA ? 4 * fq : 4 * (fq & 1);
          const int prow0 = (tl0 >> 6) + wr;
#pragma unroll
          for (int sl = 0; sl < 4; ++sl) { const int row = usep ? prow0 + 2 * (sl & 1) : 16 * sl + fr; const f32x2* e = tb + (size_t)row * strd + col;
              if (ropeA || ropeC) { T0[sl] = *(const f32x4*)e; T1[sl] = *(const f32x4*)(e + 2); } else { T0[sl] = (f32x4){1.f, 0.f, 1.f, 0.f}; T1[sl] = T0[sl]; } } }
        if (pn <= 1) {
            bf16_t* q = (bf16_t*)(r1 + R1_QA); unsigned* w = bnd + 32 + b * 16 + (pn * 4 + hw) * 2 + wl;
            run<0, 64>(acc, q + (((size_t)(b * 8 + pn * 4 + hw) * KEYS + pos0) * 64 + dc), q + (((size_t)(b * 8 + pn * 4 + 2 + hw) * KEYS + pos0) * 64 + dc), T0, T1, usep, QSA, w, w + 4);
        } else if (pn == 2) {
            const size_t o = ((size_t)(b * 2 + hw) * KEYS + pos0) * 64 + dc;
            run<1, 64>(acc, (bf16_t*)(r1 + R1_KA) + o, (bf16_t*)(r1 + R1_VA) + o, T0, T1, usep, 1.f, bnd + 64 + b * 4 + hw * 2 + wl, nullptr);
        } else if (pn == 5 || pn == 6) {
            bf16_t* q = (bf16_t*)(r1 + (pn == 5 ? R1_QC : R1_KC)); unsigned* w = bnd + (pn == 5 ? 0 : 16) + b * 8 + hw * 2 + wl;
            run<0, 64>(acc, q + (((size_t)(b * 4 + hw) * KEYS + pos0) * 64 + dc), q + (((size_t)(b * 4 + 2 + hw) * KEYS + pos0) * 64 + dc), T0, T1, usep, pn == 5 ? QSC : 1.f, w, w + 4);
        } else if (pn == 7) {
            bf16_t* q = (bf16_t*)(r1 + R1_VC);
            run<2, 64>(acc, q + (((size_t)(b * 4 + hw) * KEYS + pos0) * 64 + dc), q + (((size_t)(b * 4 + 2 + hw) * KEYS + pos0) * 64 + dc), T0, T1, usep, 1.f, nullptr, nullptr);
        } else {
            bf16_t* q = (bf16_t*)(r1 + (pn == 3 ? R1_BU : R1_BV)) + (size_t)(u.pm * 256 + wr * 64 + fr) * 256 + wc * 32 + fq * 8;
            run<2, 256>(acc, q, q + 128, T0, T1, usep, 1.f, nullptr, nullptr);
        }
    }
};

struct EpiOut {
    static constexpr bool PERM = true, AFTER_DRAIN = false, IDEM = true;
    __device__ __forceinline__ bool can_repeat() const { return xin != nullptr; }
    const float* xin;
    bf16_t* xs; const float* modl;
    template <bool F32SRC>
    __device__ __forceinline__ void body(AccRef acc, const pg8::Unit& u, int wr, int wc, int fr, int fq) const {
        const int r0 = u.pm * 256, w = r0 >> 14, cb = u.pn * 256 + wc * 32 + fq * 8;
        const float* gt = modl + (size_t)w * 6144 + 2 * D;
        f32x4 g[2][2];
#pragma unroll
        for (int bj = 0; bj < 2; ++bj)
#pragma unroll
            for (int n = 0; n < 2; ++n) g[bj][n] = *(const f32x4*)(gt + cb + bj * 128 + 4 * n);
        const size_t ro0 = (size_t)(r0 + wr * 64 + fr) * D + cb;
        if (F32SRC) {
#pragma unroll
            for (int ai = 0; ai < 2; ++ai) { f32x4 xv[4][2][2];
#pragma unroll
                for (int m = 0; m < 4; ++m)
#pragma unroll
                    for (int bj = 0; bj < 2; ++bj) { const float* p = xin + ro0 + (size_t)(ai * 128 + m * 16) * D + bj * 128; xv[m][bj][0] = *(const f32x4*)p; xv[m][bj][1] = *(const f32x4*)(p + 4); }
                asm volatile("" ::: "memory");
#pragma unroll
                for (int m = 0; m < 4; ++m)
#pragma unroll
                    for (int bj = 0; bj < 2; ++bj) { const f32x4 x0 = xv[m][bj][0] + g[bj][0] * acc[ai][bj][m][0], x1 = xv[m][bj][1] + g[bj][1] * acc[ai][bj][m][1];
                        u32x4 o; o.x = cvt_pk_f16(x0.x, x0.y); o.y = cvt_pk_f16(x0.z, x0.w); o.z = cvt_pk_f16(x1.x, x1.y); o.w = cvt_pk_f16(x1.z, x1.w);
                        *(u32x4*)(xs + ro0 + (size_t)(ai * 128 + m * 16) * D + bj * 128) = o; }
                asm volatile("" ::: "memory"); }
        } else {
            u32x4 xb[2][4][2];
#pragma unroll
            for (int ai = 0; ai < 2; ++ai)
#pragma unroll
                for (int m = 0; m < 4; ++m)
#pragma unroll
                    for (int bj = 0; bj < 2; ++bj) xb[ai][m][bj] = *(const u32x4*)(xs + ro0 + (size_t)(ai * 128 + m * 16) * D + bj * 128);
            asm volatile("" ::: "memory");
#pragma unroll
            for (int ai = 0; ai < 2; ++ai)
#pragma unroll
                for (int m = 0; m < 4; ++m)
#pragma unroll
                    for (int bj = 0; bj < 2; ++bj) { const u32x4 q = xb[ai][m][bj];
                        const f32x4 x0 = (f32x4){hflo(q.x), hfhi(q.x), hflo(q.y), hfhi(q.y)} + g[bj][0] * acc[ai][bj][m][0], x1 = (f32x4){hflo(q.z), hfhi(q.z), hflo(q.w), hfhi(q.w)} + g[bj][1] * acc[ai][bj][m][1];
                        u32x4 o; o.x = cvt_pk_f16(x0.x, x0.y); o.y = cvt_pk_f16(x0.z, x0.w); o.z = cvt_pk_f16(x1.x, x1.y); o.w = cvt_pk_f16(x1.z, x1.w);
                        *(u32x4*)(xs + ro0 + (size_t)(ai * 128 + m * 16) * D + bj * 128) = o; }
        }
    }
    __device__ __forceinline__ void operator()(AccRef acc, const pg8::Unit& u, int wr, int wc, int fr_in, int fq_in) const {
        int fr = fr_in, fq = fq_in; asm volatile("" : "+v"(fr), "+v"(fq));
        if (xin) body<true>(acc, u, wr, wc, fr, fq); else body<false>(acc, u, wr, wc, fr, fq);
    }
};

struct EpiMoe1 {
    static constexpr bool PERM = true, AFTER_DRAIN = false, IDEM = true;
    __device__ __forceinline__ bool can_repeat() const { return true; }
    bf16_t* HE;
    __device__ __forceinline__ void operator()(AccRef acc, const pg8::Unit& u, int wr, int wc, int fr_in, int fq_in) const {
        int fr = fr_in, fq = fq_in; asm volatile("" : "+v"(fr), "+v"(fq));
#pragma unroll
        for (int ai = 0; ai < 2; ++ai)
#pragma unroll
            for (int m = 0; m < 4; ++m) { const int r = u.pm * 256 + ai * 128 + wr * 64 + m * 16 + fr;
                const f32x4 g0 = acc[ai][0][m][0], g1 = acc[ai][0][m][1], u0 = acc[ai][1][m][0], u1 = acc[ai][1][m][1];
                u32x4 w; w.x = pg8::cvt_pk_bf16(silu_f(g0.x) * u0.x, silu_f(g0.y) * u0.y); w.y = pg8::cvt_pk_bf16(silu_f(g0.z) * u0.z, silu_f(g0.w) * u0.w);
                w.z = pg8::cvt_pk_bf16(silu_f(g1.x) * u1.x, silu_f(g1.y) * u1.y); w.w = pg8::cvt_pk_bf16(silu_f(g1.z) * u1.z, silu_f(g1.w) * u1.w);
                st_wt16(HE + (size_t)r * DEXP + u.pn * 128 + wc * 32 + fq * 8, w); }
    }
};
struct EpiMoe2 {
    static constexpr bool PERM = true, AFTER_DRAIN = false, IDEM = true;
    __device__ __forceinline__ bool can_repeat() const { return true; }
    bf16_t* YE; const int* rowmap; const float* wslot;
    __device__ __forceinline__ void operator()(AccRef acc, const pg8::Unit& u, int wr, int wc, int fr_in, int fq_in) const {
        int fr = fr_in, fq = fq_in; asm volatile("" : "+v"(fr), "+v"(fq));
        int drs[2][4]; float wss[2][4];
#pragma unroll
        for (int ai = 0; ai < 2; ++ai)
#pragma unroll
            for (int m = 0; m < 4; ++m) { const int r = u.pm * 256 + ai * 128 + wr * 64 + m * 16 + fr; drs[ai][m] = rowmap[r]; wss[ai][m] = wslot[r]; }
        asm volatile("" ::: "memory");
#pragma unroll
        for (int ai = 0; ai < 2; ++ai)
#pragma unroll
            for (int m = 0; m < 4; ++m) { const int dr = drs[ai][m]; const float ws = wss[ai][m];
                if (dr >= 0) {
#pragma unroll
                    for (int bj = 0; bj < 2; ++bj) { const f32x4 a = acc[ai][bj][m][0] * ws, b = acc[ai][bj][m][1] * ws;
                        u32x4 w; w.x = pg8::cvt_pk_bf16(a.x, a.y); w.y = pg8::cvt_pk_bf16(a.z, a.w); w.z = pg8::cvt_pk_bf16(b.x, b.y); w.w = pg8::cvt_pk_bf16(b.z, b.w);
                        *(u32x4*)(YE + (size_t)dr * D + u.pn * 256 + bj * 128 + wc * 32 + fq * 8) = w; } } }
    }
};
struct OneUnit { int pm, pn;
    __device__ __forceinline__ bool next(int i, pg8::Unit& u) const { if (i > 0) return false; u.pm = pm; u.pn = pn; u.be = 0; return true; }
    __device__ __forceinline__ void a_ready(const pg8::Unit&) const {}
    __device__ __forceinline__ void done(const pg8::Unit&) const {}
};
struct GroupedOrder {
    int nN, G, c, total; const LAS int* tbase; unsigned* cnt;
    __device__ __forceinline__ bool next(int i, pg8::Unit& u) const {
        int L;
        if (G == 256 && nN == 4) { const int x = c & 7, y = c >> 3; L = (i * 64 + x * 8 + (y >> 2)) * 4 + (y & 3); } else L = i * G + c;
        if (L >= total) return false;
        const int pm = L / nN, pn = L - pm * nN; int e = 0;
#pragma unroll
        for (int k = 1; k < NEXP; ++k) e += (pm >= tbase[k]) ? 1 : 0;
        u.pm = __builtin_amdgcn_readfirstlane(pm); u.pn = __builtin_amdgcn_readfirstlane(pn); u.be = __builtin_amdgcn_readfirstlane(e); return true;
    }
    __device__ __forceinline__ void a_ready(const pg8::Unit&) const {}
    __device__ __forceinline__ void done(const pg8::Unit& u) const {
        if (cnt) { asm volatile("s_waitcnt vmcnt(0)" ::: "memory");
            if (lane_id() == 0) __hip_atomic_fetch_add(cnt + 16 * u.pm, 1u, __ATOMIC_RELAXED, __HIP_MEMORY_SCOPE_AGENT); } }
};
struct GroupedOrder2 {
    int G, c, total; const LAS int* tbase; unsigned* cnt; int wave;
    __device__ __forceinline__ bool next(int i, pg8::Unit& u) const {
        int L;
        const int rf = total / 256, rem = total - rf * 256, nl = 256 - rem;
        if (G == 256 && rf >= 1 && 2 * rem <= nl) { const int x = c & 7, y = c >> 3, rho = 255 - ((x * 8 + (y >> 2)) * 4 + (y & 3));
            if (i < rf - 1) L = i * 256 + rho;
            else { const int e = i - (rf - 1); if (rho >= nl) return false; L = (rf - 1) * 256 + e * nl + rho; } }
        else L = i * G + (G - 1 - c);
        if (L >= total) return false;
        const int pm = L >> 2, pn = L & 3; int e = 0;
#pragma unroll
        for (int k = 1; k < NEXP; ++k) e += (pm >= tbase[k]) ? 1 : 0;
        u.pm = __builtin_amdgcn_readfirstlane(pm); u.pn = __builtin_amdgcn_readfirstlane(pn); u.be = __builtin_amdgcn_readfirstlane(e); return true;
    }
    __device__ __forceinline__ void a_ready(const pg8::Unit& u) const {
        if (wave == 0) { unsigned sp = 0;
            while (__hip_atomic_load(cnt + 16 * u.pm, __ATOMIC_RELAXED, __HIP_MEMORY_SCOPE_AGENT) < 32u) { __builtin_amdgcn_s_sleep(2); if (++sp > (1u << 24)) break; }
            __builtin_amdgcn_fence(__ATOMIC_ACQUIRE, "agent"); asm volatile("s_waitcnt vmcnt(0) lgkmcnt(0)" ::: "memory"); }
        asm volatile("" ::: "memory"); __builtin_amdgcn_s_barrier(); asm volatile("" ::: "memory");
    }
    __device__ __forceinline__ void done(const pg8::Unit&) const {}
};
__device__ __forceinline__ void load_tile_bases(Frame& F, int l, LAS int* tb) {
    if (F.tid == 0) { const int* cnt = (const int*)(F.ws + WS_CNT) + l * NEXP; int acc = 0;
        for (int e = 0; e < NEXP; ++e) { tb[e] = acc; acc += (cnt[e] + 255) >> 8; } tb[NEXP] = acc; }
    __syncthreads();
}


typedef float f32x4_t __attribute__((ext_vector_type(4)));
template <class Epi>
__device__ __forceinline__ void ctx_gemm(Frame& F, const bf16_t* H  , const bf16_t* Wt  , int N, const Epi& E) {
    int tid_l = F.wave * 64 + lane_id(); asm volatile("" : "+v"(tid_l));
    const int lane = tid_l & 63, wv = __builtin_amdgcn_readfirstlane(tid_l >> 6), tok = lane & 15, g = lane >> 4;
    const int ncb = N / 32, ntiles = (NCTX / 16) * ncb;
    for (int wt = F.bid * NWAVES + wv; wt < ntiles; wt += F.G * NWAVES) {
        const int tm = wt / ncb, c0 = (wt - tm * ncb) * 32;
        const bf16_t* hp = H + (size_t)(tm * 16 + tok) * D + 8 * g;
        const bf16_t* wp = Wt + (size_t)(c0 + tok) * D + 8 * g;
        f32x4_t acc0 = {0.f, 0.f, 0.f, 0.f}, acc1 = {0.f, 0.f, 0.f, 0.f};
#pragma unroll 8
        for (int ks = 0; ks < D / 32; ++ks) { const bf16x8 hf = *(const bf16x8*)(hp + ks * 32), w0 = *(const bf16x8*)(wp + ks * 32), w1 = *(const bf16x8*)(wp + (size_t)16 * D + ks * 32);
            acc0 = __builtin_amdgcn_mfma_f32_16x16x32_bf16(w0, hf, acc0, 0, 0, 0); acc1 = __builtin_amdgcn_mfma_f32_16x16x32_bf16(w1, hf, acc1, 0, 0, 0); }
        E(tm * 16 + tok, c0, g, acc0, acc1);
    }
}
struct CtxEpiProj {
    unsigned char* r1; unsigned* bnd;
    __device__ __forceinline__ void operator()(int rc, int c0, int g, f32x4_t a0, f32x4_t a1) const {
        constexpr float QSA = 0.125f * LOG2E, QSC = 0.17677669529663687f * LOG2E;
        const int b = rc >> 8, pos = rc & 255, r = NLAT + rc, pn = c0 >> 8, cc0 = c0 & 255;
        float sc = 1.f; if (pn <= 1) sc = QSA; else if (pn == 5) sc = QSC;
        a0 = a0 * sc; a1 = a1 * sc;
        const bool track = (pn <= 1) || (pn == 2 && cc0 < 128) || pn == 5 || pn == 6;
#pragma unroll
        for (int cb = 0; cb < 2; ++cb) { const f32x4_t v = cb ? a1 : a0; const int cc = cc0 + 16 * cb + 4 * g; bf16_t* dst;
            if (pn <= 1) dst = (bf16_t*)(r1 + R1_QA) + (((size_t)(b * 8 + pn * 4 + (cc >> 6)) * KEYS + pos) * 64 + (cc & 63));
            else if (pn == 2) dst = (bf16_t*)(r1 + (cc < 128 ? R1_KA : R1_VA)) + (((size_t)(b * 2 + ((cc & 127) >> 6)) * KEYS + pos) * 64 + (cc & 63));
            else if (pn == 3) dst = (bf16_t*)(r1 + R1_BU) + ((size_t)r * 256 + cc);
            else if (pn == 4) dst = (bf16_t*)(r1 + R1_BV) + ((size_t)r * 256 + cc);
            else dst = (bf16_t*)(r1 + (pn == 5 ? R1_QC : (pn == 6 ? R1_KC : R1_VC))) + (((size_t)(b * 4 + (cc >> 6)) * KEYS + pos) * 64 + (cc & 63));
            *(u32x2*)dst = (u32x2){pg8::cvt_pk_bf16(v.x, v.y), pg8::cvt_pk_bf16(v.z, v.w)}; }
        if (track) {
            float ss = (a0.x * a0.x + a0.y * a0.y) + (a0.z * a0.z + a0.w * a0.w) + (a1.x * a1.x + a1.y * a1.y) + (a1.z * a1.z + a1.w * a1.w);
            ss = swap16_add(ss, ss); ss = swap32_add(ss, ss);
            float m = ss; m = fmaxf(m, __shfl_xor(m, 1)); m = fmaxf(m, __shfl_xor(m, 2)); m = fmaxf(m, __shfl_xor(m, 4)); m = fmaxf(m, __shfl_xor(m, 8));
            const int half = (cc0 >> 5) & 1; int word;
            if (pn <= 1) word = 32 + b * 16 + (pn * 4 + (cc0 >> 6)) * 2 + half;
            else if (pn == 2) word = 64 + b * 4 + (cc0 >> 6) * 2 + half;
            else word = (pn == 5 ? 0 : 16) + b * 8 + (cc0 >> 6) * 2 + half;
            if (lane_id() == 0) atomicMax(bnd + word, __float_as_uint(m)); }
    }
};
struct CtxEpiOut {
    const float* src; bf16_t* dst; const float* gt;
    __device__ __forceinline__ void operator()(int rc, int c0, int g, f32x4_t a0, f32x4_t a1) const {
#pragma unroll
        for (int cb = 0; cb < 2; ++cb) { const int c = c0 + 16 * cb + 4 * g; const f32x4_t v = cb ? a1 : a0;
            const f32x4_t x = *(const f32x4_t*)(src + (size_t)rc * D + c), gg = *(const f32x4_t*)(gt + c);
            const f32x4_t y = x + gg * v;
            *(u32x2*)(dst + (size_t)rc * D + c) = (u32x2){cvt_pk_f16(y[0], y[1]), cvt_pk_f16(y[2], y[3])}; }
    }
};

struct ModCache { int w; f32x4 A[4], B[4]; };
__device__ __forceinline__ void route_group(Frame& F, int l, LAS float* RW, LAS int* hist, f32x4 (&v)[4][4], int rb, int nr, ModCache& mc) {
    bf16_t* H2 = (bf16_t*)(F.ws + WS_R1 + R1_H2);
    const int trow = (F.tid & 63) >> 4;
    float ss[4];
#pragma unroll
    for (int t = 0; t < 4; ++t) { float s = 0.f;
#pragma unroll
        for (int j = 0; j < 4; ++j) s += (v[t][j].x * v[t][j].x + v[t][j].y * v[t][j].y) + (v[t][j].z * v[t][j].z + v[t][j].w * v[t][j].w);
        ss[t] = s; }
#pragma unroll
    for (int t = 0; t < 4; ++t) ss[t] = wave_sum(ss[t]);
#pragma unroll
    for (int t = 0; t < 4; ++t) { const int r = rb + (t < nr ? t : 0), w = mod_w(r); const float rinv = 1.0f / sqrtf(ss[t] * (1.f / D) + EPS);
        if (w != mc.w) { mc.w = w;
            const f32x4* g = (const f32x4*)(INP(I_GFFN) + l * D) + (F.tid & 63); const f32x4* sh = (const f32x4*)mod_ptr(F, l, w, 3) + (F.tid & 63); const f32x4* sc = (const f32x4*)mod_ptr(F, l, w, 4) + (F.tid & 63);
#pragma unroll
            for (int j = 0; j < 4; ++j) { mc.A[j] = g[64 * j] * (1.f + sc[64 * j]); mc.B[j] = sh[64 * j]; } }
        u32x2* o = (u32x2*)(H2 + (size_t)r * D) + (F.tid & 63);
#pragma unroll
        for (int j = 0; j < 4; ++j) { const f32x4 h = v[t][j] * (mc.A[j] * rinv) + mc.B[j]; v[t][j] = h; if (t < nr) o[64 * j] = (u32x2){pk2(h.x, h.y), pk2(h.z, h.w)}; } }
    float lg[4][4];
#pragma unroll
    for (int t = 0; t < 4; ++t)
#pragma unroll
        for (int c = 0; c < 4; ++c) lg[t][c] = 0.f;
#pragma unroll
    for (int j = 0; j < 4; ++j)
#pragma unroll
        for (int i = 0; i < 4; ++i) { const f32x4 wq = *(const LAS f32x4*)(RW + (size_t)((j * 4 + i) * 64 + (F.tid & 63)) * 20);
#pragma unroll
            for (int t = 0; t < 4; ++t) { const float hv = v[t][j][i]; lg[t][0] += hv * wq.x; lg[t][1] += hv * wq.y; lg[t][2] += hv * wq.z; lg[t][3] += hv * wq.w; } }
    const float* brg = INP(I_BRG) + l * 4; const float* bre = INP(I_BRE) + l * 16;
    float gl[4];
#pragma unroll
    for (int c = 0; c < 4; ++c) { const float w0 = swap32_add(lg[0][c], lg[2][c]), w1 = swap32_add(lg[1][c], lg[3][c]); gl[c] = row16_sum(swap16_add(w0, w1)) + brg[c]; }
    int gsel = 0; float gm = gl[0];
#pragma unroll
    for (int c = 1; c < 4; ++c) if (gl[c] > gm) { gm = gl[c]; gsel = c; }
    float gs = 0.f;
#pragma unroll
    for (int c = 0; c < 4; ++c) gs += __expf(gl[c] - gm);
    const float ptop = 1.f / gs;
    int gr[4];
#pragma unroll
    for (int t = 0; t < 4; ++t) gr[t] = __builtin_amdgcn_readlane(gsel, 16 * t);
    float lx[4][4];
#pragma unroll
    for (int t = 0; t < 4; ++t)
#pragma unroll
        for (int c = 0; c < 4; ++c) lx[t][c] = 0.f;
#pragma unroll
    for (int j = 0; j < 4; ++j)
#pragma unroll
        for (int i = 0; i < 4; ++i) { const LAS float* rwb = RW + (size_t)((j * 4 + i) * 64 + (F.tid & 63)) * 20 + 4;
#pragma unroll
            for (int t = 0; t < 4; ++t) { const f32x4 wq = *(const LAS f32x4*)(rwb + 4 * gr[t]); const float hv = v[t][j][i];
                lx[t][0] += hv * wq.x; lx[t][1] += hv * wq.y; lx[t][2] += hv * wq.z; lx[t][3] += hv * wq.w; } }
    float le[4];
#pragma unroll
    for (int c = 0; c < 4; ++c) { const float w0 = swap32_add(lx[0][c], lx[2][c]), w1 = swap32_add(lx[1][c], lx[3][c]); le[c] = row16_sum(swap16_add(w0, w1)) + bre[4 * gsel + c]; }
    int i0 = 0; float m0 = le[0];
#pragma unroll
    for (int j = 1; j < 4; ++j) if (le[j] > m0) { m0 = le[j]; i0 = j; }
    int i1 = -1; float m1 = -3.4e38f;
#pragma unroll
    for (int j = 0; j < 4; ++j) if (j != i0 && le[j] > m1) { m1 = le[j]; i1 = j; }
    const float ex = __expf(m1 - m0), w0 = ptop / (1.f + ex), w1 = ptop * ex / (1.f + ex);
    const int e0 = gsel * 4 + i0, e1 = gsel * 4 + i1;
    if (((F.tid & 63) & 15) == 0 && trow < nr) { int* ro = (int*)(F.ws + WS_ROUTE) + (size_t)(rb + trow) * 4; ro[0] = e0; ro[1] = e1; ((float*)ro)[2] = w0; ((float*)ro)[3] = w1;
        atomicAdd((int*)hist + e0, 1); atomicAdd((int*)hist + e1, 1); }
}
__device__ __forceinline__ void route_phase(Frame& F, int l, int M) {
    LAS float* RW = (LAS float*)F.lds;
    LAS int* hist = (LAS int*)(F.lds + 81920);
    { const float* wrg = INP(I_WRG) + (size_t)l * D * 4; const float* wre = INP(I_WRE) + (size_t)l * D * 16;
#pragma unroll
      for (int m = 0; m < 2; ++m) { const int c = F.tid + NTHR * m; const int slot = ((c >> 8) * 4 + (c & 3)) * 64 + ((c >> 2) & 63);
          LAS f32x4* d = (LAS f32x4*)(RW + slot * 20); d[0] = *(const f32x4*)(wrg + c * 4);
#pragma unroll
          for (int q = 0; q < 4; ++q) d[1 + q] = *(const f32x4*)(wre + c * 16 + 4 * q); } }
    if (F.tid < NEXP) hist[F.tid] = 0;
    __syncthreads();
    const int RPW = (M + F.G - 1) / F.G, r0 = F.bid * RPW, nrows = max(0, min(RPW, M - r0));
#define RT_LOAD(V, gq_) do { const int rb_ = r0 + (gq_) * 4, nr_ = min(4, nrows - (gq_) * 4); \
        _Pragma("unroll") for (int t = 0; t < 4; ++t) { const u32x2* s_ = (const u32x2*)xs_row(F, rb_ + (t < nr_ ? t : 0)) + (F.tid & 63); \
            _Pragma("unroll") for (int j = 0; j < 4; ++j) V[t][j] = s_[64 * j]; } } while (0)
#define RT_EXPAND(V) do { _Pragma("unroll") for (int t = 0; t < 4; ++t) _Pragma("unroll") for (int j = 0; j < 4; ++j) vx[t][j] = (f32x4){hflo(V[t][j].x), hfhi(V[t][j].x), hflo(V[t][j].y), hfhi(V[t][j].y)}; } while (0)
    u32x2 vA[4][4], vB[4][4]; f32x4 vx[4][4]; ModCache mc; mc.w = -1;
    int gq = F.wave;
    if (gq * 4 < nrows) RT_LOAD(vA, gq);
    while (gq * 4 < nrows) {
        const bool h1 = (gq + NWAVES) * 4 < nrows;
        if (h1) RT_LOAD(vB, gq + NWAVES);
        RT_EXPAND(vA); route_group(F, l, RW, hist, vx, r0 + gq * 4, min(4, nrows - gq * 4), mc);
        gq += NWAVES; if (!h1) break;
        const bool h2 = (gq + NWAVES) * 4 < nrows;
        if (h2) RT_LOAD(vA, gq + NWAVES);
        RT_EXPAND(vB); route_group(F, l, RW, hist, vx, r0 + gq * 4, min(4, nrows - gq * 4), mc);
        gq += NWAVES; if (!h2) break;
    }
#undef RT_LOAD
#undef RT_EXPAND
    __syncthreads();
    if (F.tid < NEXP) ((int*)(F.ws + WS_HIST))[(size_t)(l * 256 + F.bid) * NEXP + F.tid] = hist[F.tid];
}

__device__ __forceinline__ void permute_phase(Frame& F, int l, int M) {
    LAS int* cnt = (LAS int*)F.lds; LAS int* base = cnt + 16; LAS int* wgoff = base + 32; LAS int* eids = wgoff + 16; LAS int* slots = eids + 1024;
    const int* HIST = (const int*)(F.ws + WS_HIST) + (size_t)l * 256 * NEXP;
    const int RPW = (M + F.G - 1) / F.G, r0 = F.bid * RPW, nrows = max(0, min(RPW, M - r0)), nitems = 2 * nrows;
    const int* ROUTE = (const int*)(F.ws + WS_ROUTE);
    if (F.tid < NEXP) { int tot = 0, before = 0; for (int g = 0; g < F.G; ++g) { const int h = HIST[g * NEXP + F.tid]; tot += h; before += (g < F.bid) ? h : 0; } cnt[F.tid] = tot; wgoff[F.tid] = before; }
    for (int i = F.tid; i < nitems; i += NTHR) eids[i] = ROUTE[(size_t)(r0 + (i >> 1)) * 4 + (i & 1)];
    __syncthreads();
    if (F.tid == 0) { int acc = 0; for (int e = 0; e < NEXP; ++e) { base[e] = acc; acc += (cnt[e] + 255) & ~255; } base[NEXP] = acc;
        if (F.bid == 0) { int* c = (int*)(F.ws + WS_CNT) + l * NEXP; for (int e = 0; e < NEXP; ++e) c[e] = cnt[e]; } }
    __syncthreads();
    for (int e = F.wave * 2; e < F.wave * 2 + 2; ++e) { int running = base[e] + wgoff[e];
        for (int c0 = 0; c0 < nitems; c0 += 64) { const int i = c0 + (F.tid & 63); const bool mt = (i < nitems) && (eids[i] == e);
            const unsigned long long bal = __ballot(mt); const int rank = __popcll(bal & ((1ull << (F.tid & 63)) - 1ull));
            if (mt) slots[i] = running + rank; running += __popcll(bal); } }
    __syncthreads();
    int* ROWMAP = (int*)(F.ws + WS_ROWMAP); float* WSLOT = (float*)(F.ws + WS_WSLOT);
    for (int i = F.tid; i < nitems; i += NTHR) { const int slot = slots[i], r = r0 + (i >> 1), k = i & 1;
        ROWMAP[slot] = 2 * r + k; WSLOT[slot] = ((const float*)ROUTE)[(size_t)r * 4 + 2 + k]; }
    const int gt = F.bid * NTHR + F.tid, NGT = F.G * NTHR;
    for (int e = 0; e < NEXP; ++e) { const int p0 = base[e] + cnt[e], np = base[e + 1] - p0;
        for (int p = gt; p < np; p += NGT) { ROWMAP[p0 + p] = -1; WSLOT[p0 + p] = 0.f; } }
}

__device__ __forceinline__ int crow(int r, int hi) { return (r & 3) + 8 * (r >> 2) + 4 * hi; }
typedef short v4i16_t __attribute__((ext_vector_type(4)));
__device__ __forceinline__ s16x4 vtr(const LAS unsigned char* p) { return __builtin_bit_cast(s16x4, __builtin_amdgcn_ds_read_tr16_b64_v4i16((LAS v4i16_t*)p)); }

template <int NMAP>
__device__ __forceinline__ void attn_unit(LAS unsigned char* lds, const bf16_t* qw, const bf16_t* Kb, const bf16_t* Vb, int ta_lo, int ta_n, int tb_lo, int tb_n,
                                          int qlat, float m_init, float l_init, f32x16 (&o)[NMAP][2], float (&lsum)[NMAP], int wave_in) {
    int tid_l = wave_in * 64 + lane_id(); asm volatile("" : "+v"(tid_l));
    const int tid = tid_l, lane = tid & 63, r32 = lane & 31, hi = lane >> 5;
    const int skey = tid >> 3, sch = tid & 7;
    const int kst = skey * 128 + ((sch ^ ((skey >> 1) & 7)) << 4);
    const int vst = 16384 + (sch >> 2) * 4096 + (skey >> 4) * 1024 + (skey & 15) * 64 + (sch & 3) * 16;
    const size_t goff = (size_t)skey * 64 + sch * 8;
    const int vrd = 16384 + ((lane >> 4) & 1) * 32 + (lane & 3) * 8 + (4 * hi + ((lane & 15) >> 2)) * 64;
    bf16x8 qr[4];
#pragma unroll
    for (int s = 0; s < 4; ++s) qr[s] = *(const bf16x8*)(qw + (size_t)r32 * 64 + s * 16 + hi * 8);
    float mrun[NMAP];
#pragma unroll
    for (int mp = 0; mp < NMAP; ++mp) { mrun[mp] = m_init; lsum[mp] = l_init; o[mp][0] = f32x16{}; o[mp][1] = f32x16{}; }
    const int ntile = ta_n + tb_n;
    u32x4 kreg, vreg;
    { const int T = (ta_n > 0) ? ta_lo : tb_lo; kreg = *(const u32x4*)(Kb + (size_t)T * 4096 + goff); vreg = *(const u32x4*)(Vb + (size_t)T * 4096 + goff); }
    *(LAS u32x4*)(lds + kst) = kreg; *(LAS u32x4*)(lds + vst) = vreg;
    __syncthreads();
    for (int t = 0; t < ntile; ++t) {
        const int cur = (t & 1) * 8192;
        if (t + 1 < ntile) { const int T = (t + 1 < ta_n) ? ta_lo + t + 1 : tb_lo + (t + 1 - ta_n); kreg = *(const u32x4*)(Kb + (size_t)T * 4096 + goff); vreg = *(const u32x4*)(Vb + (size_t)T * 4096 + goff); }
#pragma unroll
        for (int mp = 0; mp < NMAP; ++mp) {
            f32x16 S[2];
#pragma unroll
            for (int kb = 0; kb < 2; ++kb) { const int key = kb * 32 + r32; const LAS unsigned char* kp = lds + cur + key * 128; const int sw = (key >> 1) & 7;
                f32x16 a = f32x16{};
                constexpr int NS = (NMAP == 1) ? 4 : 2;
#pragma unroll
                for (int s = 0; s < NS; ++s) { const int sq = (NMAP == 1) ? s : 2 * mp + s; const bf16x8 kf = *(const LAS bf16x8*)(kp + (((2 * sq + hi) ^ sw) << 4));
                    a = __builtin_amdgcn_mfma_f32_32x32x16_bf16(kf, qr[sq], a, 0, 0, 0); }
                S[kb] = a; }
            if (NMAP == 1 && qlat >= 0 && t >= ta_n) { const int kl0 = (tb_lo + (t - ta_n) - 4) * 64;
#pragma unroll
                for (int kb = 0; kb < 2; ++kb)
#pragma unroll
                    for (int r = 0; r < 16; ++r) { const int dlt = kl0 + kb * 32 + crow(r, hi) - qlat; if (dlt > 128 || dlt < -128) S[kb][r] = NEGBIG; } }
            float rm = S[0][0];
#pragma unroll
            for (int r = 1; r < 16; ++r) rm = fmaxf(rm, S[0][r]);
#pragma unroll
            for (int r = 0; r < 16; ++r) rm = fmaxf(rm, S[1][r]);
            rm = fmaxf(rm, __shfl_xor(rm, 32));
            if (__any(rm > mrun[mp] + 8.f)) { const float mn = fmaxf(mrun[mp], rm), al = __builtin_amdgcn_exp2f(mrun[mp] - mn); mrun[mp] = mn; lsum[mp] *= al; o[mp][0] = o[mp][0] * al; o[mp][1] = o[mp][1] * al; }
            float ps = 0.f;
#pragma unroll
            for (int kb = 0; kb < 2; ++kb)
#pragma unroll
                for (int r = 0; r < 16; ++r) { const float p = __builtin_amdgcn_exp2f(S[kb][r] - mrun[mp]); S[kb][r] = p; ps += p; }
            lsum[mp] += ps;
#pragma unroll
            for (int kb = 0; kb < 2; ++kb)
#pragma unroll
                for (int s2 = 0; s2 < 2; ++s2) { const int ks = 2 * kb + s2;
                    u32x4 pw; pw.x = pg8::cvt_pk_bf16(S[kb][8 * s2 + 0], S[kb][8 * s2 + 1]); pw.y = pg8::cvt_pk_bf16(S[kb][8 * s2 + 2], S[kb][8 * s2 + 3]);
                    pw.z = pg8::cvt_pk_bf16(S[kb][8 * s2 + 4], S[kb][8 * s2 + 5]); pw.w = pg8::cvt_pk_bf16(S[kb][8 * s2 + 6], S[kb][8 * s2 + 7]);
                    const bf16x8 pf = __builtin_bit_cast(bf16x8, pw);
#pragma unroll
                    for (int d0 = 0; d0 < 2; ++d0) { const s16x4 lo = vtr(lds + cur + vrd + d0 * 4096 + ks * 1024), hh = vtr(lds + cur + vrd + d0 * 4096 + ks * 1024 + 512);
                        const bf16x8 vf = (bf16x8){lo[0], lo[1], lo[2], lo[3], hh[0], hh[1], hh[2], hh[3]};
                        o[mp][d0] = __builtin_amdgcn_mfma_f32_32x32x16_bf16(vf, pf, o[mp][d0], 0, 0, 0); } }
            __builtin_amdgcn_sched_barrier(0);
        }
        if (t + 1 < ntile) { *(LAS u32x4*)(lds + (cur ^ 8192) + kst) = kreg; *(LAS u32x4*)(lds + (cur ^ 8192) + vst) = vreg; }
        __syncthreads();
    }
#pragma unroll
    for (int mp = 0; mp < NMAP; ++mp) lsum[mp] = xor32_sum(lsum[mp]);
}


__device__ __forceinline__ void glds16(const void* gsrc, unsigned lds_dst) { unsigned keep;
    asm volatile("s_mov_b32 %0, m0\n\ts_mov_b32 m0, %2\n\ts_nop 0\n\tglobal_load_lds_dwordx4 %1, off\n\ts_mov_b32 m0, %0" : "=&s"(keep) : "v"(gsrc), "s"(lds_dst) : "memory"); }

__device__ __forceinline__ float dot2_ones(unsigned w, float acc) { const pg8::bf16x2_t one = {(__bf16)1.0f, (__bf16)1.0f}; return __builtin_amdgcn_fdot2_f32_bf16(__builtin_bit_cast(pg8::bf16x2_t, w), one, acc, false); }
#ifndef PROBE_A2
#define PROBE_A2 0
#endif
#ifndef A_LEAD
#define A_LEAD 4
#endif
#ifndef AF_SMPRIO
#define AF_SMPRIO 0
#endif
#ifndef AF_PVPRIO
#define AF_PVPRIO 0
#endif
#ifndef AF_PRIO
#define AF_PRIO 0
#endif
#ifndef PROBE_EXP
#define PROBE_EXP 0
#endif
#ifndef PROBE_MFMA
#define PROBE_MFMA 0
#endif
#ifndef PROBE_NOSTAG
#define PROBE_NOSTAG 0
#endif
#if PROBE_EXP
#define AF_PROBE_EXP(a, b, c, d) do { const float q0_ = __builtin_amdgcn_exp2f((a) * 0.5f), q1_ = __builtin_amdgcn_exp2f((b) * 0.5f), q2_ = __builtin_amdgcn_exp2f((c) * 0.5f), q3_ = __builtin_amdgcn_exp2f((d) * 0.5f); asm volatile("" :: "v"(q0_), "v"(q1_), "v"(q2_), "v"(q3_)); } while (0)
#else
#define AF_PROBE_EXP(a, b, c, d) do {} while (0)
#endif
#if PROBE_MFMA
#define AF_PROBE_MFMA(v0, v1, p) do { dmy = __builtin_amdgcn_mfma_f32_32x32x16_bf16(v0, p, dmy, 0, 0, 0); dmy = __builtin_amdgcn_mfma_f32_32x32x16_bf16(v1, p, dmy, 0, 0, 0); } while (0)
#else
#define AF_PROBE_MFMA(v0, v1, p) do {} while (0)
#endif
template <int NMAP, bool PRE = false, int PRE_ST = 0, int LEAD = 2>
__device__ __forceinline__ void attn_fast(LAS unsigned char* lds, const bf16_t* qw, const bf16_t* Kb, const bf16_t* Vb, int ta_lo, int ta_n, int tb_lo, int tb_n,
                                          int qlat, float l_init, f32x16 (&o)[NMAP][2], float (&lsum)[NMAP], bf16x8 (&qr)[4], int wave_in) {
    int tid_l = wave_in * 64 + lane_id(); asm volatile("" : "+v"(tid_l));
    const int tid = tid_l, lane = tid & 63, r32 = lane & 31, hi = lane >> 5, wid = __builtin_amdgcn_readfirstlane(tid >> 6);
    const bool lead = PROBE_NOSTAG ? true : (wid < 4);
    const int kkey = wid * 8 + (lane >> 3), kc = (lane & 7) ^ ((kkey >> 1) & 7);
    const size_t ksrc = (size_t)kkey * 64 + kc * 8;
    const size_t vsrc = (size_t)(16 * (wid & 3) + (lane >> 2)) * 64 + 32 * (wid >> 2) + (lane & 3) * 8;
    const int vrd = 8192 + ((lane >> 4) & 1) * 32 + (lane & 3) * 8 + (4 * hi + ((lane & 15) >> 2)) * 64;
    const int krd0 = r32 * 128, ksw0 = (r32 >> 1) & 7;
    if (!PRE) {
#pragma unroll
        for (int s = 0; s < 4; ++s) qr[s] = *(const bf16x8*)(qw + (size_t)r32 * 64 + s * 16 + hi * 8); }
    const int ntile = ta_n + tb_n;
#define AF_TILE(t) ((t) < ta_n ? ta_lo + (t) : tb_lo + (t) - ta_n)
#define AF_DMA(t) do { const int T_ = AF_TILE(t); const unsigned so_ = lds0 + (unsigned)(((t) & (2 * LEAD - 1)) * 16384 + wid * 1024); \
        glds16(Kb + (size_t)T_ * 4096 + ksrc, (unsigned)__builtin_amdgcn_readfirstlane(so_)); \
        glds16(Vb + (size_t)T_ * 4096 + vsrc, (unsigned)__builtin_amdgcn_readfirstlane(so_ + 8192u)); } while (0)
    const unsigned lds0 = (unsigned)(uintptr_t)lds;
    static_assert(!PRE || LEAD == 2, "af_begin requests two tiles");
    if (!PRE) { _Pragma("unroll") for (int k = 0; k < LEAD; ++k) if (k < ntile) AF_DMA(k); }
#pragma unroll
    for (int s = 0; s < 4; ++s) asm volatile("" : "+v"(qr[s]));
#pragma unroll
    for (int mp = 0; mp < NMAP; ++mp) { lsum[mp] = l_init; o[mp][0] = f32x16{}; o[mp][1] = f32x16{}; }
    bf16x8 pf[NMAP][4];
    f32x16 dmy = f32x16{};
#define AF_QKSM(sl, t) do { if (AF_SMPRIO) __builtin_amdgcn_s_setprio(1); float ps0[NMAP], ps1[NMAP], ps2[NMAP], ps3[NMAP]; \
        _Pragma("unroll") for (int mp = 0; mp < NMAP; ++mp) { ps0[mp] = 0.f; ps1[mp] = 0.f; ps2[mp] = 0.f; ps3[mp] = 0.f; } \
        _Pragma("unroll") for (int kb = 0; kb < 2; ++kb) { f32x16 S[NMAP]; const LAS unsigned char* kp = lds + (sl) + kb * 4096 + krd0; bf16x8 kf[4]; \
            _Pragma("unroll") for (int s = 0; s < 4; ++s) kf[s] = *(const LAS bf16x8*)(kp + (((2 * s + hi) ^ ksw0) << 4)); \
            if (NMAP == 1) { f32x16 a = f32x16{}; _Pragma("unroll") for (int s = 0; s < 4; ++s) a = __builtin_amdgcn_mfma_f32_32x32x16_bf16(kf[s], qr[s], a, 0, 0, 0); S[0] = a; } \
            else { f32x16 a = f32x16{}, b = f32x16{}; \
                a = __builtin_amdgcn_mfma_f32_32x32x16_bf16(kf[0], qr[0], a, 0, 0, 0); a = __builtin_amdgcn_mfma_f32_32x32x16_bf16(kf[1], qr[1], a, 0, 0, 0); \
                b = __builtin_amdgcn_mfma_f32_32x32x16_bf16(kf[2], qr[2], b, 0, 0, 0); b = __builtin_amdgcn_mfma_f32_32x32x16_bf16(kf[3], qr[3], b, 0, 0, 0); \
                S[0] = a; S[NMAP - 1] = b; } \
            if (NMAP == 1 && qlat >= 0 && (t) >= ta_n) { const int kl0 = (tb_lo + ((t) - ta_n) - 4) * 64; \
                if ((kl0 >> 7) != (__builtin_amdgcn_readfirstlane(qlat) >> 7)) { const int db = kl0 + kb * 32 + 4 * hi - qlat; \
                _Pragma("unroll") for (int r = 0; r < 16; ++r) { const int dlt = db + (r & 3) + 8 * (r >> 2); if (dlt > 128 || dlt < -128) S[0][r] = NEGBIG; } } } \
            _Pragma("unroll") for (int mp = 0; mp < NMAP; ++mp) { \
                _Pragma("unroll") for (int r = 0; r < 16; r += 4) { const float p0 = __builtin_amdgcn_exp2f(S[mp][r]), p1 = __builtin_amdgcn_exp2f(S[mp][r + 1]), p2 = __builtin_amdgcn_exp2f(S[mp][r + 2]), p3 = __builtin_amdgcn_exp2f(S[mp][r + 3]); \
                    ps0[mp] += p0; ps1[mp] += p1; ps2[mp] += p2; ps3[mp] += p3; S[mp][r] = p0; S[mp][r + 1] = p1; S[mp][r + 2] = p2; S[mp][r + 3] = p3; } \
                _Pragma("unroll") for (int s2 = 0; s2 < 2; ++s2) { u32x4 pw; pw.x = pg8::cvt_pk_bf16(S[mp][8 * s2 + 0], S[mp][8 * s2 + 1]); pw.y = pg8::cvt_pk_bf16(S[mp][8 * s2 + 2], S[mp][8 * s2 + 3]); \
                    pw.z = pg8::cvt_pk_bf16(S[mp][8 * s2 + 4], S[mp][8 * s2 + 5]); pw.w = pg8::cvt_pk_bf16(S[mp][8 * s2 + 6], S[mp][8 * s2 + 7]); pf[mp][2 * kb + s2] = __builtin_bit_cast(bf16x8, pw); } } } \
        _Pragma("unroll") for (int mp = 0; mp < NMAP; ++mp) lsum[mp] += (ps0[mp] + ps1[mp]) + (ps2[mp] + ps3[mp]); if (AF_SMPRIO) __builtin_amdgcn_s_setprio(0); } while (0)
#define AF_PV(sl) do { if (AF_PVPRIO) __builtin_amdgcn_s_setprio(1); _Pragma("unroll") for (int ks = 0; ks < 4; ++ks) { bf16x8 vf[2]; \
            _Pragma("unroll") for (int d0 = 0; d0 < 2; ++d0) { const s16x4 lo = vtr(lds + (sl) + vrd + d0 * 4096 + ks * 1024), hh = vtr(lds + (sl) + vrd + d0 * 4096 + ks * 1024 + 512); \
                vf[d0] = (bf16x8){lo[0], lo[1], lo[2], lo[3], hh[0], hh[1], hh[2], hh[3]}; } \
            _Pragma("unroll") for (int mp = 0; mp < NMAP; ++mp) { o[mp][0] = __builtin_amdgcn_mfma_f32_32x32x16_bf16(vf[0], pf[mp][ks], o[mp][0], 0, 0, 0); \
                o[mp][1] = __builtin_amdgcn_mfma_f32_32x32x16_bf16(vf[1], pf[mp][ks], o[mp][1], 0, 0, 0); AF_PROBE_MFMA(vf[0], vf[1], pf[mp][ks]); } } if (AF_PVPRIO) __builtin_amdgcn_s_setprio(0); } while (0)
#define AF_TOP(t) do { if (PRE && (t) < 2 && (t) + 1 < ntile) { static_assert(!PRE || PRE_ST == 8 || PRE_ST == 4 || PRE_ST == 0, "PRE_ST"); \
            if (PRE_ST == 8) asm volatile("s_waitcnt vmcnt(10)" ::: "memory"); else if (PRE_ST == 4) asm volatile("s_waitcnt vmcnt(6)" ::: "memory"); else asm volatile("s_waitcnt vmcnt(2)" ::: "memory"); } \
        else { const int ahead_ = min(LEAD - 1, ntile - 1 - (t));                 \
            if (ahead_ >= 3) asm volatile("s_waitcnt vmcnt(6)" ::: "memory"); else if (ahead_ == 2) asm volatile("s_waitcnt vmcnt(4)" ::: "memory"); \
            else if (ahead_ == 1) asm volatile("s_waitcnt vmcnt(2)" ::: "memory"); else asm volatile("s_waitcnt vmcnt(0)" ::: "memory"); } \
        __builtin_amdgcn_s_barrier(); asm volatile("" ::: "memory"); __builtin_amdgcn_sched_barrier(0); if ((t) + LEAD < ntile) AF_DMA((t) + LEAD); __builtin_amdgcn_sched_barrier(0); } while (0)
#define AF_NEXT(t) do { __builtin_amdgcn_sched_barrier(0); } while (0)
    if (AF_PRIO && lead) __builtin_amdgcn_s_setprio(1);
    if (lead) {
        for (int t = 0; t < ntile; ++t) { AF_TOP(t); const int sl = (t & (2 * LEAD - 1)) * 16384;
            AF_QKSM(sl, t); AF_PV(sl); AF_NEXT(t); }
    } else {
        { AF_TOP(0); AF_QKSM(0, 0); AF_NEXT(0); }
        for (int t = 1; t < ntile; ++t) { AF_TOP(t); const int sl = (t & (2 * LEAD - 1)) * 16384, slp = ((t - 1) & (2 * LEAD - 1)) * 16384;
            AF_PV(slp); __builtin_amdgcn_sched_barrier(0); AF_QKSM(sl, t); AF_NEXT(t); }
        { const int slp = ((ntile - 1) & (2 * LEAD - 1)) * 16384; AF_PV(slp); }
    }
#undef AF_TOP
#undef AF_NEXT
    if (AF_PRIO && lead) __builtin_amdgcn_s_setprio(0);
    if (PROBE_MFMA) asm volatile("" :: "v"(dmy));
    asm volatile("s_waitcnt lgkmcnt(0)" ::: "memory");
    __builtin_amdgcn_s_barrier();
    asm volatile("" ::: "memory");
#pragma unroll
    for (int mp = 0; mp < NMAP; ++mp) lsum[mp] = xor32_sum(lsum[mp]);
#undef AF_TILE
#undef AF_DMA
#undef AF_QKSM
#undef AF_PV
}

__device__ __forceinline__ void af_begin(LAS unsigned char* lds, const bf16_t* qw, const bf16_t* Kb, const bf16_t* Vb, int ta_lo, int ta_n, int tb_lo, int tb_n, bf16x8 (&qr)[4], int wave_in) {
    int tid_l = wave_in * 64 + lane_id(); asm volatile("" : "+v"(tid_l));
    const int tid = tid_l, lane = tid & 63, r32 = lane & 31, hi = lane >> 5, wid = __builtin_amdgcn_readfirstlane(tid >> 6);
    const int kkey = wid * 8 + (lane >> 3), kc = (lane & 7) ^ ((kkey >> 1) & 7);
    const size_t ksrc = (size_t)kkey * 64 + kc * 8;
    const size_t vsrc = (size_t)(16 * (wid & 3) + (lane >> 2)) * 64 + 32 * (wid >> 2) + (lane & 3) * 8;
#pragma unroll
    for (int s = 0; s < 4; ++s) qr[s] = *(const bf16x8*)(qw + (size_t)r32 * 64 + s * 16 + hi * 8);
    const unsigned lds0 = (unsigned)(uintptr_t)lds; const int ntile = ta_n + tb_n;
#pragma unroll
    for (int t = 0; t < 2; ++t) if (t < ntile) { const int T_ = t < ta_n ? ta_lo + t : tb_lo + t - ta_n; const unsigned so_ = lds0 + (unsigned)((t & 3) * 16384 + wid * 1024);
        glds16(Kb + (size_t)T_ * 4096 + ksrc, (unsigned)__builtin_amdgcn_readfirstlane(so_));
        glds16(Vb + (size_t)T_ * 4096 + vsrc, (unsigned)__builtin_amdgcn_readfirstlane(so_ + 8192u)); }
}

__device__ __forceinline__ void store_ot(bf16_t* yrow  , const f32x16 (&v)[2], int hi) {
#pragma unroll
    for (int d0 = 0; d0 < 2; ++d0)
#pragma unroll
        for (int g4 = 0; g4 < 4; ++g4) { u32x2 w; w.x = pg8::cvt_pk_bf16(v[d0][4 * g4], v[d0][4 * g4 + 1]); w.y = pg8::cvt_pk_bf16(v[d0][4 * g4 + 2], v[d0][4 * g4 + 3]);
            *(u32x2*)(yrow + d0 * 32 + 8 * g4 + 4 * hi) = w; }
}

__device__ __forceinline__ void store_ot_lds(bf16_t* yrow0  , const f32x16 (&v)[2], int lane, LAS unsigned char* stage) {
    const int r32 = lane & 31, hi = lane >> 5;
#pragma unroll
    for (int d0 = 0; d0 < 2; ++d0)
#pragma unroll
        for (int g4 = 0; g4 < 4; ++g4) { u32x2 w; w.x = pg8::cvt_pk_bf16(v[d0][4 * g4], v[d0][4 * g4 + 1]); w.y = pg8::cvt_pk_bf16(v[d0][4 * g4 + 2], v[d0][4 * g4 + 3]);
            *(LAS u32x2*)(stage + r32 * 144 + (d0 * 32 + 8 * g4 + 4 * hi) * 2) = w; }
    asm volatile("s_waitcnt lgkmcnt(0)" ::: "memory");
    u32x4 q[4];
#pragma unroll
    for (int j = 0; j < 4; ++j) q[j] = *(const LAS u32x4*)(stage + ((lane >> 3) + 8 * j) * 144 + (lane & 7) * 16);
#pragma unroll
    for (int j = 0; j < 4; ++j) *(u32x4*)(yrow0 + (size_t)((lane >> 3) + 8 * j) * D + (lane & 7) * 8) = q[j];
}

#ifndef REP_C
#define REP_C 1
#endif
#ifndef REP_AB
#define REP_AB 1
#endif
#ifndef MIX_DYNQ
#define MIX_DYNQ 1
#endif
__device__ __forceinline__ void mixers_phase(Frame& F, int l) {
    const bool ctxside = (l == 0);
#define MIX_LAUNDER() int tidm_ = F.wave * 64 + lane_id(); asm volatile("" : "+v"(tidm_)); const int lane = tidm_ & 63, r32 = lane & 31, hi = lane >> 5, wv = __builtin_amdgcn_readfirstlane(tidm_ >> 6); \
    unsigned char* r1; { GAS unsigned char* r1g_ = (GAS unsigned char*)(F.ws + WS_R1); asm volatile("" : "+s"(r1g_)); r1 = (unsigned char*)r1g_; } bf16_t* Y = (bf16_t*)(r1 + R1_H);
    for (int repc_ = 0; repc_ < REP_C; ++repc_) { if (repc_) __syncthreads();
        MIX_LAUNDER();
        const bf16_t *QC = (const bf16_t*)(r1 + R1_QC), *KC = (const bf16_t*)(r1 + R1_KC), *VC = (const bf16_t*)(r1 + R1_VC);
        const float lam_init = (l == 0) ? 0.2f : 0.3555090675909693f;
        float lam;
        { float a = (lane < 32) ? INP(I_LQ1)[l * 32 + lane] * INP(I_LK1)[l * 32 + lane] : 0.f, b = (lane < 32) ? INP(I_LQ2)[l * 32 + lane] * INP(I_LK2)[l * 32 + lane] : 0.f;
            lam = __expf(wave_sum(a)) - __expf(wave_sum(b)) + lam_init; }
        const int nC = 512 + (ctxside ? 8 : 0);
        for (int u = F.bid; u < nC; u += F.G) {
            int bh, pos0, ta_n; size_t yrow0;
            if (u < 512) { bh = u & 7; const int qb = u >> 3; pos0 = CTX + qb * 256 + wv * 32; ta_n = KEYS / 64; yrow0 = (size_t)(bh >> 2) * SEQ + qb * 256 + wv * 32; }
            else { bh = u - 512; pos0 = wv * 32; ta_n = CTX / 64; yrow0 = (size_t)NLAT + (bh >> 2) * CTX + wv * 32; }
            f32x16 o[2][2]; float ls[2];
            bool fast;
            { const unsigned* bw = (const unsigned*)(F.ws + WS_CTL) + CW_BND + l * 128;
              const float q0 = __uint_as_float(__hip_atomic_load(bw + bh * 2, RLX_AGENT)), q1 = __uint_as_float(__hip_atomic_load(bw + bh * 2 + 1, RLX_AGENT));
              const float k0 = __uint_as_float(__hip_atomic_load(bw + 16 + bh * 2, RLX_AGENT)), k1 = __uint_as_float(__hip_atomic_load(bw + 16 + bh * 2 + 1, RLX_AGENT));
              fast = (q0 * k0 < 3600.f) && (q1 * k1 < 3600.f); fast = __builtin_amdgcn_readfirstlane(fast ? 1 : 0) != 0; }
            bf16x8 qrc[4];
            if (fast) attn_fast<2>(F.lds, QC + ((size_t)bh * KEYS + pos0) * 64, KC + (size_t)bh * KEYS * 64, VC + (size_t)bh * KEYS * 64, 0, ta_n, 0, 0, -1, 0.f, o, ls, qrc, wv);
            else attn_unit<2>(F.lds, QC + ((size_t)bh * KEYS + pos0) * 64, KC + (size_t)bh * KEYS * 64, VC + (size_t)bh * KEYS * 64, 0, ta_n, 0, 0, -1, NEGBIG, 0.f, o, ls, wv);
            const float i1 = 1.f / ls[0], i2 = lam / ls[1];
            f32x16 v[2]; float ss = 0.f;
#pragma unroll
            for (int d0 = 0; d0 < 2; ++d0)
#pragma unroll
                for (int r = 0; r < 16; ++r) { const float x = o[0][d0][r] * i1 - o[1][d0][r] * i2; v[d0][r] = x; ss += x * x; }
            ss = xor32_sum(ss);
            const float rn = (1.f - lam_init) / sqrtf(ss * (1.f / 64.f) + EPS);
            const float* gs = INP(I_GSUB) + l * 64;
#pragma unroll
            for (int d0 = 0; d0 < 2; ++d0)
#pragma unroll
                for (int r = 0; r < 16; ++r) v[d0][r] *= rn * gs[d0 * 32 + crow(r, hi)];
            store_ot(Y + (yrow0 + r32) * D + 768 + (bh & 3) * 64, v, hi);
        }
    }
    for (int repa_ = 0; repa_ < REP_AB; ++repa_) { if (repa_) __syncthreads();
        MIX_LAUNDER();
        const bf16_t *QA = (const bf16_t*)(r1 + R1_QA), *KA = (const bf16_t*)(r1 + R1_KA), *VA = (const bf16_t*)(r1 + R1_VA);
        unsigned okmask = 0u;
        { const unsigned* bw = (const unsigned*)(F.ws + WS_CTL) + CW_BND + l * 128;
          for (int bhd = 0; bhd < 16; ++bhd) { const int b2 = bhd >> 3, hd = bhd & 7, kv = hd >> 2;
              const float kk = __uint_as_float(__hip_atomic_load(bw + 64 + b2 * 4 + kv * 2, RLX_AGENT)) + __uint_as_float(__hip_atomic_load(bw + 64 + b2 * 4 + kv * 2 + 1, RLX_AGENT));
              const float qq = __uint_as_float(__hip_atomic_load(bw + 32 + b2 * 16 + hd * 2, RLX_AGENT)) + __uint_as_float(__hip_atomic_load(bw + 32 + b2 * 16 + hd * 2 + 1, RLX_AGENT));
              const bool ok = (qq * kk < 3600.f) && (fabsf(INP(I_SINK)[l * 8 + hd]) * LOG2E < 60.f);
              okmask |= (ok ? 1u : 0u) << bhd; }
          okmask = (unsigned)__builtin_amdgcn_readfirstlane((int)okmask); }
        const int nA = 1024 + (ctxside ? 16 : 0);
        const int nCv = (l == 0 && MIX_DYNQ) ? CV_UNITS : 0, nQ = nA + nCv;
        unsigned* qctrA = (unsigned*)(F.ws + WS_CTL) + CW_MIXQ + l * 2 + repa_ * 4;
        volatile LAS int* qw_ = (volatile LAS int*)(F.lds + TBL_OFF);
        int qnxt = 0; if (tidm_ == 0) qnxt = (int)__hip_atomic_fetch_add(qctrA, 1u, __ATOMIC_RELAXED, __HIP_MEMORY_SCOPE_AGENT);
        auto pop = [&]() -> int { if (tidm_ == 0) { qw_[0] = qnxt; } __syncthreads(); int u = qw_[0]; __syncthreads();
            if (u < nQ && tidm_ == 0) qnxt = (int)__hip_atomic_fetch_add(qctrA, 1u, __ATOMIC_RELAXED, __HIP_MEMORY_SCOPE_AGENT);
            return __builtin_amdgcn_readfirstlane(u); };
        struct AU { int b, head, pos0, qlat, tb_lo, tb_n; size_t yrow0; bool fast; };
        auto decode = [&](int u, AU& a) -> int {
            if (u >= nQ) return 0;
            if (nCv) { const int cvb = (u * nCv) / nQ, cva = ((u + 1) * nCv) / nQ; if (cva != cvb) { a.b = cvb; return 2; } u -= cvb; }
            unsigned need;
            if (u < 1024) { const int kvg = u & 1, i = (u >> 1) & 255; a.b = u >> 9; a.head = 4 * kvg + (wv >> 1); const int q0 = i * 64 + (wv & 1) * 32;
                a.pos0 = CTX + q0; a.qlat = q0 + r32; const int tlo = max(i - 2, 0), thi = min(i + 2, SEQ / 64 - 1); a.tb_lo = 4 + tlo; a.tb_n = thi - tlo + 1; a.yrow0 = (size_t)a.b * SEQ + q0; need = 0xFu << (a.b * 8 + 4 * kvg); }
            else { const int q = u - 1024; a.b = q >> 3; a.head = q & 7; a.pos0 = wv * 32; a.qlat = -1; a.tb_lo = 0; a.tb_n = 0; a.yrow0 = (size_t)NLAT + a.b * CTX + wv * 32; need = 1u << (a.b * 8 + a.head); }
            a.fast = (okmask & need) == need;
            return 1; };
#define AQ(a) (QA + ((size_t)((a).b * 8 + (a).head) * KEYS + (a).pos0) * 64)
#define AK(a) (KA + (size_t)((a).b * 2 + ((a).head >> 2)) * KEYS * 64)
#define AV(a) (VA + (size_t)((a).b * 2 + ((a).head >> 2)) * KEYS * 64)
        AU cur; int kind = decode(pop(), cur); bool pre = false; bf16x8 qr[4];
        while (kind) {
            if (kind == 2) { p0_items(F, P0_EARLY + cur.b * CV_PER_UNIT + wv, NWAVES, CV_PER_UNIT / NWAVES, (LAS float*)(F.lds + wv * 16384), lane); kind = decode(pop(), cur); pre = false; continue; }
            f32x16 o[1][2]; float ls[1];
            const float sink2 = INP(I_SINK)[l * 8 + cur.head] * LOG2E;
            if (cur.fast) { const float li = hi == 0 ? __builtin_amdgcn_exp2f(sink2) : 0.f;
                if (pre) attn_fast<1, true, 8>(F.lds, AQ(cur), AK(cur), AV(cur), 0, CTX / 64, cur.tb_lo, cur.tb_n, cur.qlat, li, o, ls, qr, wv);
                else { attn_fast<1, false, 0, A_LEAD>(F.lds, AQ(cur), AK(cur), AV(cur), 0, CTX / 64, cur.tb_lo, cur.tb_n, cur.qlat, li, o, ls, qr, wv);
#if PROBE_A2
                    asm volatile("" :: "v"(o[0][0]), "v"(o[0][1]), "v"(ls[0]) : "memory"); attn_fast<1, false, 0, A_LEAD>(F.lds, AQ(cur), AK(cur), AV(cur), 0, CTX / 64, cur.tb_lo, cur.tb_n, cur.qlat, li, o, ls, qr, wv);
#endif
                } }
            else attn_unit<1>(F.lds, AQ(cur), AK(cur), AV(cur), 0, CTX / 64, cur.tb_lo, cur.tb_n, cur.qlat, sink2, hi == 0 ? 1.f : 0.f, o, ls, wv);
            AU nx; const int kn = decode(pop(), nx); const bool pren = (A_LEAD == 2) && (kn == 1) && nx.fast;
            if (pren) af_begin(F.lds, AQ(nx), AK(nx), AV(nx), 0, CTX / 64, nx.tb_lo, nx.tb_n, qr, wv);
            const float inv = 1.f / ls[0];
            f32x16 v[2]; v[0] = o[0][0] * inv; v[1] = o[0][1] * inv;
            store_ot(Y + (cur.yrow0 + r32) * D + cur.head * 64, v, hi);
            cur = nx; kind = kn; pre = pren;
        }
#undef AQ
#undef AK
#undef AV
    }
    for (int repb_ = 0; repb_ < REP_AB; ++repb_) { if (repb_) __syncthreads();
        MIX_LAUNDER();
        const bf16_t *BU = (const bf16_t*)(r1 + R1_BU), *BV = (const bf16_t*)(r1 + R1_BV);
        const int nB = (ctxside ? NROW / 128 : NLAT / 128) * 4;
        LAS bf16_t* vnT = (LAS bf16_t*)F.lds;
        const bf16_t* WS = (const bf16_t*)(F.ws + WS_WSTOK) + (size_t)l * 4 * 128 * 128;
        unsigned* qctrB = (unsigned*)(F.ws + WS_CTL) + CW_MIXQ + l * 2 + 1 + repb_ * 4;
        volatile LAS int* qw_ = (volatile LAS int*)(F.lds + TBL_OFF);
        int qnxt = 0; if (MIX_DYNQ && tidm_ == 0) qnxt = (int)__hip_atomic_fetch_add(qctrB, 1u, __ATOMIC_RELAXED, __HIP_MEMORY_SCOPE_AGENT);
        for (int u = (F.bid + F.G - 24) % F.G; ; u += F.G) {
            if (MIX_DYNQ) { if (tidm_ == 0) { qw_[0] = qnxt; } __syncthreads(); u = qw_[0]; __syncthreads();
                if (u < nB && tidm_ == 0) qnxt = (int)__hip_atomic_fetch_add(qctrB, 1u, __ATOMIC_RELAXED, __HIP_MEMORY_SCOPE_AGENT); }
            u = __builtin_amdgcn_readfirstlane(u);
            if (u >= nB) break;
            const int g = u & 3, rc = u >> 2, row0 = rc * 128;
            { const int ftid = tidm_;
                const int p = ftid >> 2, dq = ftid & 3;
                const u32x4* src = (const u32x4*)(BV + (size_t)(row0 + p) * 256 + g * 64 + dq * 16);
                const u32x4 a = src[0], b4 = src[1]; float x[16];
                x[0] = bflo(a.x); x[1] = bfhi(a.x); x[2] = bflo(a.y); x[3] = bfhi(a.y); x[4] = bflo(a.z); x[5] = bfhi(a.z); x[6] = bflo(a.w); x[7] = bfhi(a.w);
                x[8] = bflo(b4.x); x[9] = bfhi(b4.x); x[10] = bflo(b4.y); x[11] = bfhi(b4.y); x[12] = bflo(b4.z); x[13] = bfhi(b4.z); x[14] = bflo(b4.w); x[15] = bfhi(b4.w);
                float s = 0.f;
#pragma unroll
                for (int i = 0; i < 16; ++i) { x[i] = gelu_tanh(x[i]); s += x[i]; }
                s += __shfl_xor(s, 1); s += __shfl_xor(s, 2);
                const float mu = s * (1.f / 64.f); float q = 0.f;
#pragma unroll
                for (int i = 0; i < 16; ++i) { x[i] -= mu; q += x[i] * x[i]; }
                q += __shfl_xor(q, 1); q += __shfl_xor(q, 2);
                const float rs = 1.f / sqrtf(q * (1.f / 64.f) + EPS);
                const float* gt = INP(I_GTOK) + (l * 4 + g) * 64 + dq * 16;
#pragma unroll
                for (int i = 0; i < 16; ++i) vnT[(dq * 16 + i) * 136 + p] = (bf16_t)(pg8::cvt_pk_bf16(x[i] * rs * gt[i], 0.f) & 0xffffu);
            }
            __syncthreads();
            const int pblk = wv >> 1, dblk = wv & 1;
            f32x16 acc = f32x16{};
            const bf16_t* wsr = WS + ((size_t)g * 128 + pblk * 32 + r32) * 128 + hi * 8;
#pragma unroll
            for (int s = 0; s < 8; ++s) { const bf16x8 wf = *(const bf16x8*)(wsr + s * 16);
                const bf16x8 vfr = *(const LAS bf16x8*)(vnT + (dblk * 32 + r32) * 136 + s * 16 + hi * 8);
                acc = __builtin_amdgcn_mfma_f32_32x32x16_bf16(vfr, wf, acc, 0, 0, 0); }
            const int p = pblk * 32 + r32;
            const float bsp = INP(I_BSTOK)[(l * 4 + g) * 128 + p];
            const bf16_t* up = BU + (size_t)(row0 + p) * 256 + g * 64 + dblk * 32 + 4 * hi;
            bf16_t* yp = Y + (size_t)(row0 + p) * D + 512 + g * 64 + dblk * 32 + 4 * hi;
#pragma unroll
            for (int g4 = 0; g4 < 4; ++g4) { const u32x2 uw = *(const u32x2*)(up + 8 * g4);
                const float y0 = gelu_tanh(bflo(uw.x)) * (acc[4 * g4] + bsp), y1 = gelu_tanh(bfhi(uw.x)) * (acc[4 * g4 + 1] + bsp), y2 = gelu_tanh(bflo(uw.y)) * (acc[4 * g4 + 2] + bsp), y3 = gelu_tanh(bfhi(uw.y)) * (acc[4 * g4 + 3] + bsp);
                *(u32x2*)(yp + 8 * g4) = (u32x2){pg8::cvt_pk_bf16(y0, y1), pg8::cvt_pk_bf16(y2, y3)}; }
            __syncthreads();
        }
    }
}

#ifndef REP_N0
#define REP_N0 1
#endif
#ifndef REP_P0
#define REP_P0 1
#endif
#ifndef REP_RT
#define REP_RT 1
#endif
#ifndef REP_PM
#define REP_PM 1
#endif
#ifndef REP_GEMM
#define REP_GEMM 1
#endif
#ifndef REP_MIX
#define REP_MIX 1
#endif
#ifndef MOE_MERGE
#define MOE_MERGE 1
#endif
struct Args { const float* in[27]; float* out; unsigned char* ws; int ph_lo, ph_hi; };
__global__ void __launch_bounds__(NTHR, 2) fwd_kernel(Args args) {
    extern __shared__ __attribute__((aligned(16))) unsigned char lds_raw[];
    Frame F;
    F.lds = (LAS unsigned char*)lds_raw;
    F.tid = threadIdx.x; F.wave = __builtin_amdgcn_readfirstlane(F.tid >> 6);
    F.G = gridDim.x; F.bid = blockIdx.x;
    F.out = args.out; F.ws = args.ws;
    volatile LAS unsigned* MISC = (volatile LAS unsigned*)(F.lds + MISC_OFF);
    for (int u = F.tid; u < 64; u += NTHR) MISC[u] = 0u;
    __syncthreads();
    const int lo = args.ph_lo, hi = args.ph_hi;
    unsigned* barw = (unsigned*)(F.ws + WS_CTL) + CW_BAR;
    XcdBarrier bar; bar.bar = barw; bar.x = 0; bar.st = nullptr;
    const bool multi = (hi - lo) > 1;
    if (multi) bar = xcd_barrier_post(barw, MISC + 8, F.wave);
#ifdef ONLY_PH
#define IN(k) (((k) == 0 ? 0 : (((k) - 1) % 8) + 1) == ONLY_PH && lo <= (k) && (k) < hi)
#else
#define IN(k) (lo <= (k) && (k) < hi)
#endif
#define SEAM(k) do { if (IN(k) && IN((k) + 1)) xcd_barrier(bar, F.wave); LAUNDER(); } while (0)
#define LAUNDER() do { asm volatile("" : "+v"(F.tid)); asm volatile("" : "+s"(F.wave), "+s"(F.G), "+s"(F.bid)); { GAS unsigned char* ws_ = (GAS unsigned char*)F.ws; GAS float* out_ = (GAS float*)F.out; asm volatile("" : "+s"(ws_), "+s"(out_)); F.ws = (unsigned char*)ws_; F.out = (float*)out_; } } while (0)
    LAS int* tb = (LAS int*)(F.lds + TBL_OFF);

    LAUNDER();
    if (IN(0)) for (int rep_ = 0; rep_ < REP_P0; ++rep_) { if (rep_) { __syncthreads(); LAUNDER(); } p0_prologue(F); } SEAM(0);
    for (int l = 0; l < 2; ++l) {
        const int pb = 1 + 8 * l;
        const int Mlay = (l == 0) ? NROW : NLAT;
        if (IN(pb + 0)) { if (l == 0) { for (int rep_ = 0; rep_ < REP_N0; ++rep_) { if (rep_) LAUNDER(); norm_phase<0>(F, l); } } else norm_phase<1>(F, l);
        } SEAM(pb + 0);
        if (IN(pb + 1)) for (int rep_ = 0; rep_ < REP_GEMM; ++rep_) {
            if (rep_) { __syncthreads(); LAUNDER(); }
            pg8::Gemm g{(const bf16_t*)(F.ws + WS_R1 + R1_H), (const bf16_t*)(F.ws + WS_WIN) + (size_t)l * DIN * D, NROW, DIN, D, 0, nullptr};
            pg8::StaticOrder S; S.init(NLAT, DIN, F.G, F.bid);
            EpiProj E{F.ws + WS_R1, (const f32x2*)(F.ws + WS_TABA), (const f32x2*)(F.ws + WS_TABC), (unsigned*)(F.ws + WS_CTL) + CW_BND + l * 128};
            pg8::gemm_phase<EpiProj, pg8::StaticOrder, true, true>(F.lds, g, S, E, F.wave);
            { LAUNDER(); CtxEpiProj CE{F.ws + WS_R1, (unsigned*)(F.ws + WS_CTL) + CW_BND + l * 128};
              ctx_gemm<CtxEpiProj>(F, (const bf16_t*)(F.ws + WS_R1 + R1_H) + (size_t)NLAT * D, (const bf16_t*)(F.ws + WS_WIN) + (size_t)l * DIN * D, DIN, CE); }
        } SEAM(pb + 1);
        if (IN(pb + 2)) for (int rep_ = 0; rep_ < REP_MIX; ++rep_) { if (rep_) { __syncthreads(); LAUNDER(); } mixers_phase(F, l); } SEAM(pb + 2);
        if (IN(pb + 3)) {
            pg8::Gemm g{(const bf16_t*)(F.ws + WS_R1 + R1_H), (const bf16_t*)(F.ws + WS_WOUT) + (size_t)l * D * D, NLAT, D, D, 0, nullptr};
            pg8::StaticOrder S; S.init(NLAT, D, F.G, F.bid);
            EpiOut E{l == 0 ? INP(I_X) : (const float*)nullptr, (bf16_t*)(F.ws + WS_XS), (const float*)(F.ws + WS_MOD) + (size_t)l * 3 * 6144};
            pg8::gemm_phase<EpiOut, pg8::StaticOrder, true, true>(F.lds, g, S, E, F.wave);
            if (l == 0) { LAUNDER(); CtxEpiOut CE{INP(I_CTX), (bf16_t*)(F.ws + WS_XS) + (size_t)NLAT * D, (const float*)(F.ws + WS_MOD) + (size_t)(l * 3 + 2) * 6144 + 2 * D};
              ctx_gemm<CtxEpiOut>(F, (const bf16_t*)(F.ws + WS_R1 + R1_H) + (size_t)NLAT * D, (const bf16_t*)(F.ws + WS_WOUT) + (size_t)l * D * D, D, CE); }
        } SEAM(pb + 3);
        if (IN(pb + 4)) for (int rep_ = 0; rep_ < REP_RT; ++rep_) { if (rep_) { __syncthreads(); LAUNDER(); } route_phase(F, l, Mlay); } SEAM(pb + 4);
        if (IN(pb + 5)) for (int rep_ = 0; rep_ < REP_PM; ++rep_) { if (rep_) { __syncthreads(); LAUNDER(); } permute_phase(F, l, Mlay); } SEAM(pb + 5);
        if (IN(pb + 6)) for (int rep_ = 0; rep_ < REP_GEMM; ++rep_) {
            LAUNDER(); __syncthreads(); load_tile_bases(F, l, tb);
            LAS int* gmap = (LAS int*)(F.lds + GMAP_OFF);
            GroupedOrder S{4, F.G, F.bid, tb[NEXP] * 4, tb, MOE_MERGE ? (unsigned*)(F.ws + WS_CTL) + CW_MOEC + l * 8192 : (unsigned*)nullptr};
            { pg8::Unit uu; const int* ROWMAP = (const int*)(F.ws + WS_ROWMAP);
              for (int i = 0; i < GMAP_UNITS && S.next(i, uu); ++i) if (F.tid < 256) gmap[i * 256 + F.tid] = ROWMAP[uu.pm * 256 + F.tid];
              __syncthreads(); }
            pg8::Gemm g{(const bf16_t*)(F.ws + WS_R1 + R1_H2), (const bf16_t*)(F.ws + WS_WGU) + (size_t)l * NEXP * 1024 * D, MOE_ROWS, 1024, D, (size_t)1024 * D * 2, gmap};
            EpiMoe1 E{(bf16_t*)(F.ws + WS_R1 + R1_HE)};
            pg8::gemm_phase<EpiMoe1, GroupedOrder, true, true, true>(F.lds, g, S, E, F.wave);
        } if (!MOE_MERGE) SEAM(pb + 6); else LAUNDER();
        if (IN(pb + 7)) for (int rep_ = 0; rep_ < REP_GEMM; ++rep_) {
            LAUNDER(); __syncthreads(); load_tile_bases(F, l, tb);
            pg8::Gemm g{(const bf16_t*)(F.ws + WS_R1 + R1_HE), (const bf16_t*)(F.ws + WS_WD) + (size_t)l * NEXP * D * DEXP, MOE_ROWS, D, DEXP, (size_t)D * DEXP * 2, nullptr};
#if MOE_MERGE
            GroupedOrder2 S{F.G, F.bid, tb[NEXP] * 4, tb, (unsigned*)(F.ws + WS_CTL) + CW_MOEC + l * 8192, F.wave};
#else
            GroupedOrder S{4, F.G, F.bid, tb[NEXP] * 4, tb, nullptr};
#endif
            EpiMoe2 E{(bf16_t*)(F.ws + WS_R2), (const int*)(F.ws + WS_ROWMAP), (const float*)(F.ws + WS_WSLOT)};
#if MOE_MERGE
            pg8::gemm_phase<EpiMoe2, GroupedOrder2, true, true>(F.lds, g, S, E, F.wave);
#else
            pg8::gemm_phase<EpiMoe2, GroupedOrder, true, true>(F.lds, g, S, E, F.wave);
#endif
        } SEAM(pb + 7);
    }
    if (IN(17)) { norm_phase<2>(F, 1); }
#undef IN
#undef SEAM
}

#ifndef MK_PER_PHASE
#define MK_PER_PHASE 0
#endif
extern "C" void kernel_launch(void* const* d_in, const int* in_sizes, int n_in, void* d_out, int out_size, void* d_ws, size_t ws_size, hipStream_t stream) {
    static int grid = 0;
    if (grid == 0) {
        if (n_in != 27 || out_size != NLAT * D || ws_size < WS_END) { fprintf(stderr, "kernel_launch: unexpected problem (n_in %d out %d ws %zu)\n", n_in, out_size, ws_size); grid = -1; return; }
        if (hipFuncSetAttribute((const void*)fwd_kernel, hipFuncAttributeMaxDynamicSharedMemorySize, LDS_BYTES) != hipSuccess) { fprintf(stderr, "kernel_launch: hipFuncSetAttribute failed\n"); grid = -1; return; }
        int dev = 0, cus = 0, per_cu = 0;
        if (hipGetDevice(&dev) != hipSuccess || hipDeviceGetAttribute(&cus, hipDeviceAttributeMultiprocessorCount, dev) != hipSuccess) { grid = -1; return; }
        if (hipOccupancyMaxActiveBlocksPerMultiprocessor(&per_cu, (const void*)fwd_kernel, NTHR, LDS_BYTES) != hipSuccess || per_cu < 1) fprintf(stderr, "kernel_launch: occupancy query says %d\n", per_cu);
        (void)hipGetLastError();
        grid = cus < 256 ? cus : 256;
    }
    if (grid < 0) return;
    if (hipMemsetAsync((char*)d_ws + WS_CTL, 0, CTL_ZERO_BYTES, stream) != hipSuccess) return;
    Args a{};
    for (int i = 0; i < 27; ++i) a.in[i] = (const float*)d_in[i];
    a.out = (float*)d_out; a.ws = (unsigned char*)d_ws;
#if MK_PER_PHASE
    for (int p = 0; p < N_PHASES; ++p) { a.ph_lo = p; a.ph_hi = p + 1; hipLaunchKernelGGL(fwd_kernel, dim3(grid), dim3(NTHR), LDS_BYTES, stream, a); }
#else
    a.ph_lo = 0; a.ph_hi = N_PHASES;
    hipLaunchKernelGGL(fwd_kernel, dim3(grid), dim3(NTHR), LDS_BYTES, stream, a);
#endif
}
```

```cpp
#include <hip/hip_runtime.h>
#include <cstdio>
#include <cstdint>
#ifndef PROBE_EPI2
#define PROBE_EPI2 0
#endif

#define LAS __attribute__((address_space(3)))
#define GAS __attribute__((address_space(1)))
typedef unsigned short bf16_t;
typedef unsigned short f16s_t;
typedef _Float16 f16x2_t __attribute__((ext_vector_type(2)));
typedef short bf16x8 __attribute__((ext_vector_type(8)));
typedef short s16x4 __attribute__((ext_vector_type(4)));
typedef float f32x4 __attribute__((ext_vector_type(4)));
typedef float f32x2 __attribute__((ext_vector_type(2)));
typedef float f32x16 __attribute__((ext_vector_type(16)));
typedef unsigned u32x4 __attribute__((ext_vector_type(4)));
typedef unsigned u32x2 __attribute__((ext_vector_type(2)));

typedef float f32x2_h __attribute__((ext_vector_type(2)));
__device__ __forceinline__ unsigned cvt_pk_f16(float lo, float hi) { f32x2_h v = {lo, hi}; f16x2_t h = __builtin_convertvector(v, f16x2_t); return __builtin_bit_cast(unsigned, h); }
__device__ __forceinline__ float hflo(unsigned w) { return (float)__builtin_bit_cast(f16x2_t, w)[0]; }
__device__ __forceinline__ float hfhi(unsigned w) { return (float)__builtin_bit_cast(f16x2_t, w)[1]; }

namespace pg8 {
#define PG8_LAS __attribute__((address_space(3)))
constexpr int BM = 256, BK = 64, HALF = 128, HTB = HALF * BK * 2, STAGE_BYTES = 8 * HTB, NXCD = 8, WGM = 8;
__host__ __device__ __forceinline__ int lds_byte(int r, int c) { const int st = (r >> 4) * 2 + (c >> 5), rr = r & 15, cc = c & 31, ob = rr * 64 + cc * 2; return st * 1024 + (ob ^ (((ob >> 9) & 1) << 5)); }
__host__ __device__ __forceinline__ void stage_rc(int b, int& R, int& C) { const int st = b / 1024, sb = b % 1024, swz = sb ^ (((sb >> 9) & 1) << 5); R = (st >> 1) * 16 + swz / 64; C = (st & 1) * 32 + (swz % 64) / 2; }
__host__ __device__ __forceinline__ int perm32(int rho) { const int n = rho >> 4, i = rho & 15; return 8 * (i >> 2) + 4 * n + (i & 3); }

struct Unit { int pm, pn, be; };
struct Gemm { const bf16_t* A; const bf16_t* Bt; int M, N, K; size_t bstride; const PG8_LAS int* gmap; };

struct StaticOrder {
    int nM, nN, nwg, G, c;
    __host__ __device__ void init(int M, int N, int G_, int c_) { nM = M / BM; nN = N / BM; nwg = nM * nN; G = G_; c = c_; }
    __host__ __device__ bool next(int i, Unit& u) const {
        const long L = (long)i * G + c; if (L >= nwg) return false;
        int wgid = (int)L; { const int q = nwg / NXCD, r = nwg % NXCD, xcd = wgid % NXCD, off = wgid / NXCD; wgid = (xcd < r ? xcd * (q + 1) : r * (q + 1) + (xcd - r) * q) + off; }
        const int nig = WGM * nN, gid = wgid / nig, fm = gid * WGM, gsz = (nM - fm) < WGM ? (nM - fm) : WGM;
        u.pm = fm + ((wgid % nig) % gsz); u.pn = (wgid % nig) / gsz; u.be = 0; return true;
    }
    __device__ __forceinline__ void a_ready(const Unit&) const {}
    __device__ __forceinline__ void done(const Unit&) const {}
};
typedef __bf16 bf16x2_t __attribute__((ext_vector_type(2)));
__device__ __forceinline__ unsigned cvt_pk_bf16(float lo, float hi) { f32x2 v = {lo, hi}; bf16x2_t b = __builtin_convertvector(v, bf16x2_t); return __builtin_bit_cast(unsigned, b); }

template <class Epi, class Sched, bool ALIGN_EPI = false, bool SP2 = false, bool GATHER = false>
__device__ __forceinline__ void gemm_phase(PG8_LAS unsigned char* lds, const Gemm g, const Sched& S, const Epi& E) {
    int tid_l = threadIdx.x; asm volatile("" : "+v"(tid_l));
    const int tid = tid_l, wid = __builtin_amdgcn_readfirstlane(tid >> 6), lane = tid & 63, wr = wid >> 2, wc = wid & 3, fr = lane & 15, fq = lane >> 4;
    const int K = g.K, nt = K / BK;
    unsigned voffA[2], voffB[2];
#pragma unroll
    for (int i = 0; i < 2; ++i) { int R, C; stage_rc(tid * 16 + i * 8192, R, C); const int Rb = Epi::PERM ? ((R & ~31) + perm32(R & 31)) : R;
        voffA[i] = (unsigned)(R * K + C) * 2u; voffB[i] = (unsigned)(Rb * K + C) * 2u; }
    const size_t kstep = (size_t)(BK * 2);
    const size_t hstep = (size_t)HALF * K * 2;
    const size_t tstep = GATHER ? 0 : 2 * hstep;
    const unsigned ldsw = (unsigned)wid * 1024u;
    const int aoff = lds_byte(wr * 64 + fr, fq * 8), boff = lds_byte(wc * 32 + fr, fq * 8);
#define PG8_SA(b, h) (((b) * 2 + (h)) * HTB)
#define PG8_SB(b, h) ((4 + (b) * 2 + (h)) * HTB)
#define PG8_STAGE(bufoff, gbase, voff) do { _Pragma("unroll") for (int _i = 0; _i < 2; ++_i) \
        __builtin_amdgcn_global_load_lds((const unsigned*)((const char*)(gbase) + (voff)[_i]), (PG8_LAS unsigned*)(lds + (bufoff) + ldsw + _i * 8192), 16, 0, 0); } while (0)
#define PG8_LDA(dst, b, h) do { _Pragma("unroll") for (int m = 0; m < 4; ++m) _Pragma("unroll") for (int k = 0; k < 2; ++k) dst[m][k] = *(const PG8_LAS bf16x8*)(lds + PG8_SA(b, h) + aoff + m * 2048 + k * 1024); } while (0)
#define PG8_LDB(dst, b, h) do { _Pragma("unroll") for (int n = 0; n < 2; ++n) _Pragma("unroll") for (int k = 0; k < 2; ++k) dst[n][k] = *(const PG8_LAS bf16x8*)(lds + PG8_SB(b, h) + boff + n * 2048 + k * 1024); } while (0)
#define PG8_MMA(ai, bj, At, Bt) do { __builtin_amdgcn_s_setprio(1); _Pragma("unroll") for (int m = 0; m < 4; ++m) _Pragma("unroll") for (int n = 0; n < 2; ++n) _Pragma("unroll") for (int k = 0; k < 2; ++k) \
        acc[ai][bj][m][n] = __builtin_amdgcn_mfma_f32_16x16x32_bf16(Bt[n][k], At[m][k], acc[ai][bj][m][n], 0, 0, 0); __builtin_amdgcn_s_setprio(0); } while (0)
#define PG8_WAIT_V(n) asm volatile("s_waitcnt vmcnt(" #n ")" ::: "memory")
#define PG8_WAIT_L(n) asm volatile("s_waitcnt lgkmcnt(" #n ")" ::: "memory")
#define PG8_BAR __builtin_amdgcn_s_barrier()
#define PG8_SCHED __builtin_amdgcn_sched_barrier(0)
    Unit cur, nxt; int ui = 0;
    if (!S.next(0, cur)) return;
    f32x4 acc[2][2][4][2];
#pragma unroll
    for (int a = 0; a < 2; ++a)
#pragma unroll
        for (int b = 0; b < 2; ++b)
#pragma unroll
            for (int m = 0; m < 4; ++m)
#pragma unroll
                for (int n = 0; n < 2; ++n) acc[a][b][m][n] = (f32x4){0.f, 0.f, 0.f, 0.f};
    bf16x8 At[4][2], B0[2][2], B1[2][2];
    unsigned vA0[2] = {0u, 0u}, vA1[2] = {0u, 0u}, nvA0[2] = {0u, 0u}, nvA1[2] = {0u, 0u};
#define PG8_GOFF(dst0, dst1, unit) do { _Pragma("unroll") for (int i_ = 0; i_ < 2; ++i_) { int R_, C_; stage_rc(tid * 16 + i_ * 8192, R_, C_); \
        const int m0_ = g.gmap[(unit) * 256 + R_], m1_ = g.gmap[(unit) * 256 + 128 + R_]; \
        dst0[i_] = (unsigned)((m0_ < 0 ? 0 : (m0_ >> 1)) * K + C_) * 2u; dst1[i_] = (unsigned)((m1_ < 0 ? 0 : (m1_ >> 1)) * K + C_) * 2u; } } while (0)
#define PG8_STAGE_A(bufoff, p, h, nx) do { if constexpr (GATHER) { unsigned tv_[2]; \
        tv_[0] = (nx) ? ((h) ? nvA1[0] : nvA0[0]) : ((h) ? vA1[0] : vA0[0]); tv_[1] = (nx) ? ((h) ? nvA1[1] : nvA0[1]) : ((h) ? vA1[1] : vA0[1]); PG8_STAGE(bufoff, p, tv_); } \
        else PG8_STAGE(bufoff, (p) + (h) * hstep, voffA); } while (0)
    const char* cA = (const char*)g.A + (size_t)cur.pm * tstep; const size_t btstep = 2 * (size_t)HALF * K * 2; const char* cB = (const char*)g.Bt + (size_t)cur.be * g.bstride + (size_t)cur.pn * btstep;
    S.a_ready(cur);
    if constexpr (GATHER) PG8_GOFF(vA0, vA1, 0);
    if constexpr (SP2) {
        PG8_STAGE(PG8_SB(0, 0), cB, voffB); PG8_STAGE(PG8_SB(0, 1), cB + hstep, voffB); PG8_STAGE_A(PG8_SA(0, 0), cA, 0, false); PG8_STAGE_A(PG8_SA(0, 1), cA, 1, false);
        if (wr == 1) PG8_BAR;
        PG8_WAIT_V(2); PG8_BAR;
        PG8_STAGE(PG8_SB(1, 0), cB + kstep, voffB); PG8_STAGE_A(PG8_SA(1, 0), cA + kstep, 0, false); PG8_STAGE(PG8_SB(1, 1), cB + hstep + kstep, voffB);
        PG8_WAIT_V(6); PG8_BAR;
    } else {
        PG8_STAGE(PG8_SB(0, 0), cB, voffB); PG8_STAGE(PG8_SA(0, 0), cA, voffA); PG8_STAGE(PG8_SB(0, 1), cB + hstep, voffB); PG8_STAGE(PG8_SA(0, 1), cA + hstep, voffA);
        if (wr == 1) PG8_BAR;
        PG8_WAIT_V(4); PG8_BAR;
        PG8_STAGE(PG8_SB(1, 0), cB + kstep, voffB); PG8_STAGE(PG8_SA(1, 0), cA + kstep, voffA); PG8_STAGE(PG8_SB(1, 1), cB + hstep + kstep, voffB);
        PG8_WAIT_V(6); PG8_BAR;
    }
    for (;;) {
        const bool has_next = S.next(ui + 1, nxt);
        const char* nA = has_next ? (const char*)g.A + (size_t)nxt.pm * tstep : cA; const char* nB = has_next ? (const char*)g.Bt + (size_t)nxt.be * g.bstride + (size_t)nxt.pn * btstep : cB;
        for (int t = 0; t < nt; t += 2) {
            const bool last = (t == nt - 2);
            const char* a1 = cA + (size_t)(t + 1) * kstep;
            const char* a2 = last ? nA : cA + (size_t)(t + 2) * kstep; const char* b2 = last ? nB : cB + (size_t)(t + 2) * kstep;
            const char* a3 = a2 + kstep; const char* b3 = b2 + kstep;
            if (last && has_next) S.a_ready(nxt);
            if constexpr (GATHER) { if (last) { const int un_ = has_next ? ui + 1 : ui; PG8_GOFF(nvA0, nvA1, un_); } }
            if constexpr (SP2) {
            PG8_LDB(B0, 0, 0); PG8_LDB(B1, 0, 1); PG8_SCHED; PG8_LDA(At, 0, 0); PG8_STAGE_A(PG8_SA(1, 1), a1, 1, false);
            PG8_WAIT_V(8); PG8_WAIT_L(0); PG8_BAR; PG8_MMA(0, 0, At, B0); PG8_MMA(0, 1, At, B1); PG8_BAR; PG8_SCHED;
            PG8_LDA(At, 0, 1); PG8_STAGE(PG8_SB(0, 0), b2, voffB); PG8_STAGE(PG8_SB(0, 1), b2 + hstep, voffB); PG8_STAGE_A(PG8_SA(0, 0), a2, 0, last);
            PG8_WAIT_V(8); PG8_WAIT_L(0); PG8_BAR; PG8_MMA(1, 0, At, B0); PG8_MMA(1, 1, At, B1); PG8_BAR; PG8_SCHED;
            PG8_LDB(B0, 1, 0); PG8_LDB(B1, 1, 1); PG8_SCHED; PG8_LDA(At, 1, 0); PG8_STAGE_A(PG8_SA(0, 1), a2, 1, last);
            PG8_WAIT_V(8); PG8_WAIT_L(0); PG8_BAR; PG8_MMA(0, 0, At, B0); PG8_MMA(0, 1, At, B1); PG8_BAR; PG8_SCHED;
            PG8_LDA(At, 1, 1); PG8_STAGE(PG8_SB(1, 0), b3, voffB); PG8_STAGE(PG8_SB(1, 1), b3 + hstep, voffB); PG8_STAGE_A(PG8_SA(1, 0), a3, 0, last);
            PG8_WAIT_V(8); PG8_WAIT_L(0); PG8_BAR; PG8_MMA(1, 0, At, B0); PG8_MMA(1, 1, At, B1); PG8_BAR; PG8_SCHED;
            } else {
            PG8_LDB(B0, 0, 0); PG8_SCHED; PG8_LDA(At, 0, 0); PG8_STAGE(PG8_SA(1, 1), a1 + hstep, voffA);
            PG8_WAIT_L(8); PG8_BAR; PG8_WAIT_L(0); PG8_MMA(0, 0, At, B0); PG8_BAR; PG8_SCHED;
            PG8_LDB(B1, 0, 1); PG8_STAGE(PG8_SB(0, 0), b2, voffB);
            PG8_BAR; PG8_WAIT_L(0); PG8_MMA(0, 1, At, B1); PG8_BAR;
            PG8_LDA(At, 0, 1); PG8_STAGE(PG8_SA(0, 0), a2, voffA);
            PG8_BAR; PG8_WAIT_L(0); PG8_MMA(1, 0, At, B0); PG8_BAR; PG8_SCHED;
            PG8_STAGE(PG8_SB(0, 1), b2 + hstep, voffB);
            PG8_WAIT_V(6); PG8_BAR; PG8_MMA(1, 1, At, B1); PG8_BAR;
            PG8_LDB(B0, 1, 0); PG8_SCHED; PG8_LDA(At, 1, 0); PG8_STAGE(PG8_SA(0, 1), a2 + hstep, voffA);
            PG8_WAIT_L(8); PG8_BAR; PG8_WAIT_L(0); PG8_MMA(0, 0, At, B0); PG8_BAR; PG8_SCHED;
            PG8_LDB(B1, 1, 1); PG8_STAGE(PG8_SB(1, 0), b3, voffB);
            PG8_BAR; PG8_WAIT_L(0); PG8_MMA(0, 1, At, B1); PG8_BAR;
            PG8_LDA(At, 1, 1); PG8_STAGE(PG8_SA(1, 0), a3, voffA);
            PG8_BAR; PG8_WAIT_L(0); PG8_MMA(1, 0, At, B0); PG8_BAR; PG8_SCHED;
            PG8_STAGE(PG8_SB(1, 1), b3 + hstep, voffB);
            PG8_WAIT_V(6); PG8_BAR; PG8_MMA(1, 1, At, B1); PG8_BAR;
            }
        }
        if constexpr (ALIGN_EPI) { if (wr == 0) PG8_BAR; }
#if PROBE_EPI2
        if constexpr (!Epi::AFTER_DRAIN) {
            int nrep_ = 1; if constexpr (Epi::IDEM) { if (E.can_repeat()) nrep_ = 2; } asm volatile("" : "+s"(nrep_));
            for (int rep_ = 0; rep_ < nrep_; ++rep_) { asm volatile("" ::: "memory");
                _Pragma("unroll") for (int a = 0; a < 2; ++a) _Pragma("unroll") for (int b = 0; b < 2; ++b) _Pragma("unroll") for (int m = 0; m < 4; ++m) _Pragma("unroll") for (int n = 0; n < 2; ++n) asm volatile("" : "+v"(acc[a][b][m][n]));
                E(acc, cur, wr, wc, fr, fq); }
            S.done(cur); }
#else
        if constexpr (!Epi::AFTER_DRAIN) { E(acc, cur, wr, wc, fr, fq); S.done(cur); }
#endif
        if (!has_next) break;
#pragma unroll
        for (int a = 0; a < 2; ++a)
#pragma unroll
            for (int b = 0; b < 2; ++b)
#pragma unroll
                for (int m = 0; m < 4; ++m)
#pragma unroll
                    for (int n = 0; n < 2; ++n) acc[a][b][m][n] = (f32x4){0.f, 0.f, 0.f, 0.f};
        cur = nxt; cA = nA; cB = nB; ++ui;
        if constexpr (GATHER) { vA0[0] = nvA0[0]; vA0[1] = nvA0[1]; vA1[0] = nvA1[0]; vA1[1] = nvA1[1]; }
        if constexpr (ALIGN_EPI) { if (wr == 1) PG8_BAR; }
    }
    PG8_WAIT_V(0);
    if constexpr (!ALIGN_EPI) { if (wr == 0) PG8_BAR; }
    PG8_BAR;
    if constexpr (Epi::AFTER_DRAIN) { E.fused(acc, cur, wr, wc, fr, fq, lds, wid, lane); S.done(cur); }
#undef PG8_GOFF
#undef PG8_STAGE_A
#undef PG8_SA
#undef PG8_SB
#undef PG8_STAGE
#undef PG8_LDA
#undef PG8_LDB
#undef PG8_MMA
#undef PG8_WAIT_V
#undef PG8_WAIT_L
#undef PG8_BAR
#undef PG8_SCHED
}
}

constexpr int D = 1024, SEQ = 16384, CTX = 256, NB = 2;
constexpr int NLAT = NB * SEQ, NCTX = NB * CTX, NROW = NLAT + NCTX;
constexpr int KEYS = CTX + SEQ;
constexpr int DIN = 2048, NEXP = 16, DEXP = 512, MOE_ROWS = 70656;
constexpr float EPS = 1e-6f, LOG2E = 1.4426950408889634f, NEGBIG = -1e30f;
constexpr int NWAVES = 8, NTHR = 512, CTXP_WGS = 16;
constexpr int N_PHASES = 18;

constexpr size_t MiB = 1u << 20;
constexpr size_t WS_CTL = 0, CTL_ZERO_BYTES = 1 * MiB;
constexpr size_t WS_MOD = 1 * MiB;
constexpr size_t WS_TABA = WS_MOD + 160 * 1024;
constexpr size_t WS_TABC = WS_TABA + 32 * 1024;
constexpr size_t WS_WSTOK = 1 * MiB + 256 * 1024;
constexpr size_t WS_HIST = 1 * MiB + 512 * 1024;
constexpr size_t WS_CNT = WS_HIST + 64 * 1024;
constexpr size_t WS_ROUTE = 2 * MiB;
constexpr size_t WS_ROWMAP = 3 * MiB;
constexpr size_t WS_WSLOT = 3 * MiB + 320 * 1024;
constexpr size_t WS_WIN = 4 * MiB, WS_WOUT = 12 * MiB, WS_WGU = 16 * MiB, WS_WD = 80 * MiB;
constexpr size_t WS_R1 = 112 * MiB, WS_R2 = 315 * MiB, WS_XS = 445 * MiB, WS_END = 510 * MiB;
constexpr size_t R1_QA = 0, R1_KA = 34078720, R1_VA = 42598400, R1_QC = 51118080, R1_KC = 68157440, R1_VC = 85196800, R1_BU = 102236160, R1_BV = 119275520;
constexpr size_t R1_H = 130 * MiB, R1_H2 = 138 * MiB, R1_HE = 0;
static_assert(R1_BV + (size_t)NROW * 256 * 2 == 130 * MiB && (size_t)MOE_ROWS * D * 2 == 138 * MiB && WS_R1 + 203 * MiB == WS_R2 && R1_H2 + (size_t)NROW * D * 2 == 203 * MiB && WS_R2 + (size_t)2 * NROW * D * 2 == WS_XS && WS_XS + (size_t)NROW * D * 2 == WS_END, "ws map");
constexpr int CW_TMO = 0, CW_BAR = 4096, CW_BND = 8192, CW_MIXQ = 9216, CW_MOEC = 32768;

constexpr int RING_BYTES = 131072, MISC_OFF = RING_BYTES + 320, TBL_OFF = RING_BYTES + 1024, GMAP_OFF = TBL_OFF + 128, GMAP_UNITS = 8, LDS_BYTES = 147456;
static_assert(GMAP_OFF + GMAP_UNITS * 1024 <= LDS_BYTES, "lds map");

#define RLX_AGENT __ATOMIC_RELAXED, __HIP_MEMORY_SCOPE_AGENT
__device__ __forceinline__ unsigned f2bf(float f) { unsigned u = __builtin_bit_cast(unsigned, f); return (u + 0x7fffu + ((u >> 16) & 1u)) >> 16; }
__device__ __forceinline__ unsigned pk2(float lo, float hi) { return pg8::cvt_pk_bf16(lo, hi); }
__device__ __forceinline__ float bf2f(unsigned short h) { return __builtin_bit_cast(float, (unsigned)h << 16); }
__device__ __forceinline__ float bflo(unsigned w) { return __builtin_bit_cast(float, w << 16); }
__device__ __forceinline__ float bfhi(unsigned w) { return __builtin_bit_cast(float, w & 0xffff0000u); }
template <int CTRL> __device__ __forceinline__ float dpp_xadd(float v) { return v + __uint_as_float(__builtin_amdgcn_update_dpp(0u, __float_as_uint(v), CTRL, 0xf, 0xf, false)); }
__device__ __forceinline__ float row16_sum(float v) {
    v = dpp_xadd<0xB1>(v); v = dpp_xadd<0x4E>(v); v = dpp_xadd<0x141>(v); v = dpp_xadd<0x140>(v); return v; }
__device__ __forceinline__ float swap16_add(float a, float b) { auto r = __builtin_amdgcn_permlane16_swap(__float_as_uint(a), __float_as_uint(b), false, false); return __uint_as_float(r[0]) + __uint_as_float(r[1]); }
__device__ __forceinline__ float swap32_add(float a, float b) { auto r = __builtin_amdgcn_permlane32_swap(__float_as_uint(a), __float_as_uint(b), false, false); return __uint_as_float(r[0]) + __uint_as_float(r[1]); }
__device__ __forceinline__ float xor32_sum(float v) { return swap32_add(v, v); }
__device__ __forceinline__ float wave_sum(float v) { v = row16_sum(v); v = swap16_add(v, v); return swap32_add(v, v); }
__device__ __forceinline__ float silu_f(float x) { return x * __builtin_amdgcn_rcpf(1.f + __expf(-x)); }
__device__ __forceinline__ float gelu_tanh(float x) { const float z = 0.7978845608028654f * (x + 0.044715f * x * x * x); return x * __builtin_amdgcn_rcpf(1.f + __expf(-2.f * z)); }

#define XB_TMO      128
#define XB_XCNT(j)  (256  + 64 * (j))
#define XB_XSUB(j)  (1280 + 64 * (j))
#define XB_XGEN(j)  (2304 + 64 * (j))
#define XB_TOP      3328
#define XB_TOPGEN   3392
#define XCD_BAR_WORDS 3456
#define XB_SPIN_CAP (1u << 22)
__device__ __forceinline__ unsigned xb_ld(unsigned* p)              { return __hip_atomic_load(p, __ATOMIC_RELAXED, __HIP_MEMORY_SCOPE_AGENT); }
__device__ __forceinline__ unsigned xb_add(unsigned* p, unsigned v) { return __hip_atomic_fetch_add(p, v, __ATOMIC_RELAXED, __HIP_MEMORY_SCOPE_AGENT); }
__device__ __forceinline__ unsigned xb_xcc_id() { return (unsigned)__builtin_amdgcn_s_getreg((3 << 11) | 20) & 0xFu; }
#define XB_SPIN(cond, bar) do { unsigned _sp = 0; while (cond) { __builtin_amdgcn_s_sleep(1); \
    if ((++_sp & 255u) == 0u) { if (xb_ld(&(bar)[XB_TMO])) break; if (_sp > XB_SPIN_CAP) { atomicAdd(&(bar)[XB_TMO], 1u); break; } } } } while (0)
struct XcdBarrier { unsigned* bar; unsigned x; volatile LAS unsigned* st; };
__device__ __forceinline__ XcdBarrier xcd_barrier_post(unsigned* bar, volatile LAS unsigned* st) {
    XcdBarrier b; b.bar = bar; b.x = xb_xcc_id(); b.st = st;
    if (threadIdx.x == 0) (void)xb_add(&bar[XB_XCNT(b.x)], 1u);
    return b;
}
__device__ __forceinline__ void xcd_barrier_complete(unsigned* bar, unsigned x, unsigned& nloc, unsigned& nx) {
    const unsigned G = gridDim.x * gridDim.y * gridDim.z;
    unsigned sum, cnt, mine, sp = 0u;
    for (;;) {
        sum = 0u; cnt = 0u; mine = 0u;
#pragma unroll
        for (unsigned j = 0; j < 16; ++j) { const unsigned c = xb_ld(&bar[XB_XCNT(j)]); sum += c; cnt += (c > 0u) ? 1u : 0u; mine = (j == x) ? c : mine; }
        if (sum == G) break;
        __builtin_amdgcn_s_sleep(1);
        if ((++sp & 255u) == 0u) { if (xb_ld(&bar[XB_TMO])) break; if (sp > XB_SPIN_CAP) { atomicAdd(&bar[XB_TMO], 1u); break; } }
    }
    nloc = mine > 0u ? mine : 1u; nx = cnt > 0u ? cnt : 1u;
}
__device__ __forceinline__ void xcd_barrier(const XcdBarrier& b) {
    asm volatile("s_waitcnt vmcnt(0)" ::: "memory");
    __syncthreads();
    if (threadIdx.x == 0) {
        unsigned* bar = b.bar;
        __builtin_amdgcn_s_waitcnt(0);
        unsigned nloc = b.st[0], nx = b.st[1];
        if (nloc == 0u) { xcd_barrier_complete(bar, b.x, nloc, nx); b.st[0] = nloc; b.st[1] = nx; }
        const unsigned old = xb_add(&bar[XB_XSUB(b.x)], 1u);
        const unsigned gen = old / nloc;
        if (old + 1u == (gen + 1u) * nloc) {
            __builtin_amdgcn_fence(__ATOMIC_RELEASE, "agent");
            asm volatile("s_waitcnt vmcnt(0)" ::: "memory");
            const unsigned og = xb_add(&bar[XB_TOP], 1u);
            const unsigned tg = og / nx;
            if (og + 1u == (tg + 1u) * nx) xb_add(&bar[XB_TOPGEN], 1u);
            else XB_SPIN(xb_ld(&bar[XB_TOPGEN]) == tg, bar);
            __builtin_amdgcn_fence(__ATOMIC_ACQUIRE, "agent");
            xb_add(&bar[XB_XGEN(b.x)], 1u);
            asm volatile("s_waitcnt vmcnt(0)" ::: "memory");
        } else {
            XB_SPIN(xb_ld(&bar[XB_XGEN(b.x)]) == gen, bar);
            __builtin_amdgcn_fence(__ATOMIC_ACQUIRE, "agent");
            asm volatile("s_waitcnt vmcnt(0)" ::: "memory");
        }
    }
    __syncthreads();
}

struct Frame {
    LAS unsigned char* lds;
    int tid, lane, wave, G, bid;
    float* out; unsigned char* ws;
};
#define INP(i) ((const float*)((const GAS float* const __attribute__((address_space(4)))*)__builtin_amdgcn_kernarg_segment_ptr())[i])
enum { I_X = 0, I_C, I_CTX, I_CCTX, I_WADA, I_BADA, I_GMIX, I_WIN, I_SINK, I_WSTOK, I_BSTOK, I_GTOK, I_LQ1, I_LK1, I_LQ2, I_LK2, I_GSUB, I_WOUT, I_GFFN, I_WRG, I_BRG, I_WRE, I_BRE, I_WGATE, I_WUP, I_WDOWN, I_GFINAL };

__device__ __forceinline__ bf16_t* xs_row(const Frame& F, int r) { return (bf16_t*)(F.ws + WS_XS) + (size_t)r * D; }
__device__ __forceinline__ const float* xin_row(const Frame& F, int r) { return r < NLAT ? INP(I_X) + (size_t)r * D : INP(I_CTX) + (size_t)(r - NLAT) * D; }
__device__ __forceinline__ int mod_w(int r) { return r < NLAT ? (r >> 14) : 2; }
__device__ __forceinline__ const float* mod_ptr(const Frame& F, int l, int w, int chunk) { return (const float*)(F.ws + WS_MOD) + ((size_t)(l * 3 + w) * 6 + chunk) * D; }

__device__ __forceinline__ int rope_perm(int j, int ptype) {
    if (ptype == 1) return (j >> 1) + 16 * (j & 1);
    if (ptype == 2) return j < 16 ? (j >> 1) + 8 * (j & 1) : 16 + ((j - 16) >> 1) + 8 * (j & 1);
    return j;
}
struct P0Item { const float* src; bf16_t* dst; int K, N, ptype; };
constexpr int IT_IN = 2 * 16 * 64, IT_OUT = 2 * 16 * 32, IT_G = 32 * 256, IT_U = 32 * 256, IT_D = 32 * 256;
constexpr int P0_NITEMS = IT_IN + IT_OUT + IT_G + IT_U + IT_D;
#ifndef P0_DEFER
#define P0_DEFER 0
#endif
constexpr int P0_EARLY = P0_DEFER ? IT_IN / 2 : P0_NITEMS;
constexpr int CV_PER_UNIT = 64;
constexpr int CV_UNITS = (P0_NITEMS - P0_EARLY) / CV_PER_UNIT;
static_assert((P0_NITEMS - P0_EARLY) % CV_PER_UNIT == 0, "conversion units");
__device__ __forceinline__ P0Item p0_decode(const Frame& F, int it) {
    P0Item q; int r = it;
    if (r < IT_IN) { const int l = r >> 10, x = r & 1023, kb = x >> 6, nb = x & 63, n0 = nb * 32;
        q.ptype = n0 < 640 ? 1 : ((n0 >= 1280 && n0 < 1792) ? 2 : 0); q.K = D; q.N = DIN;
        q.src = INP(I_WIN) + (size_t)l * D * DIN + (size_t)(kb * 64) * DIN + n0; q.dst = (bf16_t*)(F.ws + WS_WIN) + ((size_t)l * DIN + n0) * D + kb * 64; return q; }
    r -= IT_IN;
    if (r < IT_OUT) { const int l = r >> 9, x = r & 511, kb = x >> 5, nb = x & 31, n0 = nb * 32;
        q.ptype = 0; q.K = D; q.N = D;
        q.src = INP(I_WOUT) + (size_t)l * D * D + (size_t)(kb * 64) * D + n0; q.dst = (bf16_t*)(F.ws + WS_WOUT) + ((size_t)l * D + n0) * D + kb * 64; return q; }
    r -= IT_OUT;
    if (r < IT_G + IT_U) { const int up = r >= IT_G; if (up) r -= IT_G; const int idx = r >> 8, x = r & 255, kb = x >> 4, nb = x & 15, n0 = nb * 32;
        const int drow = (n0 >> 7) * 256 + (n0 & 127) + (up ? 128 : 0);
        q.ptype = 0; q.K = D; q.N = DEXP;
        q.src = (up ? INP(I_WUP) : INP(I_WGATE)) + (size_t)idx * D * DEXP + (size_t)(kb * 64) * DEXP + n0; q.dst = (bf16_t*)(F.ws + WS_WGU) + ((size_t)idx * 1024 + drow) * D + kb * 64; return q; }
    r -= IT_G + IT_U;
    { const int idx = r >> 8, x = r & 255, kb = x >> 5, nb = x & 31, n0 = nb * 32;
        q.ptype = 0; q.K = DEXP; q.N = D;
        q.src = INP(I_WDOWN) + (size_t)idx * DEXP * D + (size_t)(kb * 64) * D + n0; q.dst = (bf16_t*)(F.ws + WS_WD) + ((size_t)idx * D + n0) * DEXP + kb * 64; return q; }
}
__device__ __forceinline__ void p0_load(const P0Item& q, float (&v)[32], int lane) {
#pragma unroll
    for (int i = 0; i < 32; ++i) v[i] = q.src[(size_t)(2 * i + (lane >> 5)) * q.N + (lane & 31)];
}
__device__ __forceinline__ void p0_lds_write(const float (&v)[32], LAS float* scr, int lane) {
#pragma unroll
    for (int i = 0; i < 32; ++i) scr[(2 * i + (lane >> 5)) * 33 + (lane & 31)] = v[i];
}
__device__ __forceinline__ void p0_finish(const P0Item& q, LAS float* scr, int lane) {
    asm volatile("s_waitcnt lgkmcnt(0)" ::: "memory");
    const int c = lane & 7;
#pragma unroll
    for (int j = 0; j < 4; ++j) { const int n = (lane >> 3) + 8 * j; const LAS float* s = scr + (8 * c) * 33 + rope_perm(n, q.ptype);
        u32x4 o; o.x = pk2(s[0 * 33], s[1 * 33]); o.y = pk2(s[2 * 33], s[3 * 33]); o.z = pk2(s[4 * 33], s[5 * 33]); o.w = pk2(s[6 * 33], s[7 * 33]);
        *(u32x4*)(q.dst + (size_t)n * q.K + 8 * c) = o; }
    asm volatile("s_waitcnt lgkmcnt(0)" ::: "memory");
}
__device__ __forceinline__ void p0_items(const Frame& F, int it0, int stride, int n, LAS float* scr, int lane) {
    if (n <= 0) return;
    float v[32];
    P0Item cur = p0_decode(F, it0);
    p0_load(cur, v, lane);
    for (int j = 0; j < n; ++j) {
        p0_lds_write(v, scr, lane);
        P0Item nxt = cur;
        if (j + 1 < n) { nxt = p0_decode(F, it0 + (j + 1) * stride); p0_load(nxt, v, lane); }
        p0_finish(cur, scr, lane);
        cur = nxt;
    }
}
__device__ __forceinline__ void p0_prologue(Frame& F) {
    LAS float* scr = (LAS float*)(F.lds + F.wave * 16384);
    { const int gwr = (F.G - 1 - F.bid) * NWAVES + F.wave, NGW = F.G * NWAVES;
      p0_items(F, gwr, NGW, gwr < P0_EARLY ? (P0_EARLY - gwr + NGW - 1) / NGW : 0, scr, F.lane); }
    __syncthreads();
    for (int it = F.bid; it < 2 * 96; it += F.G) {
        const int l = it / 96, n = (it % 96) * 64 + F.lane;
        const float* wa = INP(I_WADA) + (size_t)l * D * 6144 + n;
        const int kb = F.wave * 128;
        float s0[2], s1[2], s2[2];
#pragma unroll
        for (int h = 0; h < 2; ++h) { s0[h] = silu_f(INP(I_C)[kb + 64 * h + F.lane]); s1[h] = silu_f(INP(I_C)[D + kb + 64 * h + F.lane]); s2[h] = silu_f(INP(I_CCTX)[kb + 64 * h + F.lane]); }
        float a0 = 0.f, a1 = 0.f, a2 = 0.f;
#pragma unroll
        for (int kk = 0; kk < 2; ++kk) { float w[64];
#pragma unroll
            for (int i = 0; i < 64; ++i) w[i] = wa[(size_t)(kb + kk * 64 + i) * 6144];
            __builtin_amdgcn_sched_barrier(0);
#pragma unroll
            for (int i = 0; i < 64; ++i) {
                a0 += __int_as_float(__builtin_amdgcn_readlane(__float_as_int(s0[kk]), i)) * w[i];
                a1 += __int_as_float(__builtin_amdgcn_readlane(__float_as_int(s1[kk]), i)) * w[i];
                a2 += __int_as_float(__builtin_amdgcn_readlane(__float_as_int(s2[kk]), i)) * w[i]; } }
        LAS float* part = (LAS float*)(F.lds + F.wave * 16384 + 12288);
        part[F.lane] = a0; part[64 + F.lane] = a1; part[128 + F.lane] = a2;
        __syncthreads();
        if (F.wave < 3) { float s = INP(I_BADA)[l * 6144 + n];
#pragma unroll
            for (int w = 0; w < 8; ++w) s += ((LAS float*)(F.lds + w * 16384 + 12288))[F.wave * 64 + F.lane];
            ((float*)(F.ws + WS_MOD))[(size_t)(l * 3 + F.wave) * 6144 + n] = s; }
        __syncthreads();
    }
    const int gt = F.bid * NTHR + F.tid, NGT = F.G * NTHR;
    for (int i = gt; i < 256 * 16 + 256 * 8; i += NGT) {
        if (i < 4096) { const int pos = i >> 4, j = i & 15; const float ang = (float)pos * powf(10000.f, -(float)j / 16.f);
            ((f32x2*)(F.ws + WS_TABA))[i] = (f32x2){cosf(ang), sinf(ang)}; }
        else { const int q = i - 4096, pos = q >> 3, j = q & 7; const float ang = (float)pos * powf(10000.f, -(float)j / 8.f);
            ((f32x2*)(F.ws + WS_TABC))[q] = (f32x2){cosf(ang), sinf(ang)}; }
    }
    for (int i = gt; i < 2 * 4 * 128 * 128; i += NGT) ((bf16_t*)(F.ws + WS_WSTOK))[i] = (bf16_t)f2bf(INP(I_WSTOK)[i]);
}

template <int MODE>
__device__ __forceinline__ void norm_phase(Frame& F, int l) {
    const int gw = F.bid * NWAVES + F.wave, NGW = F.G * NWAVES;
    bf16_t* H = (bf16_t*)(F.ws + WS_R1 + R1_H);
    const bf16_t* YE = (const bf16_t*)(F.ws + WS_R2);
    const int lp = (MODE == 2) ? 1 : 0, M = (MODE == 2) ? NLAT : NROW;
    int wcur = -1; f32x4 A[4], B[4], G[4], GF[4];
    if (MODE == 2) { const f32x4* g = (const f32x4*)INP(I_GFINAL) + F.lane;
#pragma unroll
        for (int j = 0; j < 4; ++j) GF[j] = g[64 * j]; }
    for (int rb = gw * 4; rb < M; rb += NGW * 4) {
        const int w = mod_w(rb);
        if (w != wcur) { wcur = w;
            if (MODE != 0) { const f32x4* gt2 = (const f32x4*)mod_ptr(F, lp, w, 5) + F.lane;
#pragma unroll
                for (int j = 0; j < 4; ++j) G[j] = gt2[64 * j]; }
            if (MODE != 2) { const f32x4* g = (const f32x4*)(INP(I_GMIX) + l * D) + F.lane; const f32x4* sh = (const f32x4*)mod_ptr(F, l, w, 0) + F.lane; const f32x4* sc = (const f32x4*)mod_ptr(F, l, w, 1) + F.lane;
#pragma unroll
                for (int j = 0; j < 4; ++j) { A[j] = g[64 * j] * (1.f + sc[64 * j]); B[j] = sh[64 * j]; } } }
        f32x4 v[4][4];
        if (MODE == 0) {
#pragma unroll
            for (int t = 0; t < 4; ++t) { const f32x4* s = (const f32x4*)xin_row(F, rb + t) + F.lane;
#pragma unroll
                for (int j = 0; j < 4; ++j) v[t][j] = s[64 * j]; }
        } else {
            u32x2 ya[4][4], yb[4][4], xq[4][4];
#pragma unroll
            for (int t = 0; t < 4; ++t) { const int r = rb + t; const u32x2* s = (const u32x2*)xs_row(F, r) + F.lane;
                const u32x2* y0 = (const u32x2*)(YE + (size_t)(2 * r) * D) + F.lane; const u32x2* y1 = (const u32x2*)(YE + (size_t)(2 * r + 1) * D) + F.lane;
#pragma unroll
                for (int j = 0; j < 4; ++j) { xq[t][j] = s[64 * j]; ya[t][j] = y0[64 * j]; yb[t][j] = y1[64 * j]; } }
#pragma unroll
            for (int t = 0; t < 4; ++t) { const int r = rb + t;
#pragma unroll
                for (int j = 0; j < 4; ++j) { const u32x2 a = ya[t][j], b = yb[t][j], x = xq[t][j];
                    f32x4 y; y.x = bflo(a.x) + bflo(b.x); y.y = bfhi(a.x) + bfhi(b.x); y.z = bflo(a.y) + bflo(b.y); y.w = bfhi(a.y) + bfhi(b.y);
                    v[t][j] = (f32x4){hflo(x.x), hfhi(x.x), hflo(x.y), hfhi(x.y)} + G[j] * y; }
                if (MODE == 1) { bf16_t* xr = xs_row(F, r);
#pragma unroll
                    for (int j = 0; j < 4; ++j) ((u32x2*)xr + F.lane)[64 * j] = (u32x2){cvt_pk_f16(v[t][j].x, v[t][j].y), cvt_pk_f16(v[t][j].z, v[t][j].w)}; } }
        }
        float ss[4];
#pragma unroll
        for (int t = 0; t < 4; ++t) { float s = 0.f;
#pragma unroll
            for (int j = 0; j < 4; ++j) s += (v[t][j].x * v[t][j].x + v[t][j].y * v[t][j].y) + (v[t][j].z * v[t][j].z + v[t][j].w * v[t][j].w);
            ss[t] = s; }
#pragma unroll
        for (int t = 0; t < 4; ++t) ss[t] = wave_sum(ss[t]);
#pragma unroll
        for (int t = 0; t < 4; ++t) { const int r = rb + t; const float rinv = 1.0f / sqrtf(ss[t] * (1.f / D) + EPS);
            if (MODE == 2) { f32x4* o = (f32x4*)(F.out + (size_t)r * D) + F.lane;
#pragma unroll
                for (int j = 0; j < 4; ++j) o[64 * j] = v[t][j] * (GF[j] * rinv); }
            else { u32x2* o = (u32x2*)(H + (size_t)r * D) + F.lane;
#pragma unroll
                for (int j = 0; j < 4; ++j) { const f32x4 h = v[t][j] * (A[j] * rinv) + B[j]; o[64 * j] = (u32x2){pk2(h.x, h.y), pk2(h.z, h.w)}; } } }
    }
}

typedef const f32x4 (&AccRef)[2][2][4][2];

__device__ __forceinline__ void st_wt16(void* p, u32x4 v) { asm volatile("global_store_dwordx4 %0, %1, off sc0 sc1\n\ts_nop 1" :: "v"((GAS void*)p), "v"(v) : "memory"); }
#ifndef PROBE_ST2
#define PROBE_ST2 0
#endif
#ifndef EPIPROJ_WT
#define EPIPROJ_WT 0
#endif
struct EpiProj {
    static constexpr bool PERM = true, AFTER_DRAIN = false, IDEM = true;
    __device__ __forceinline__ bool can_repeat() const { return true; }
    unsigned char* r1; const f32x2* tabA; const f32x2* tabC; unsigned* bnd;
    static __device__ __forceinline__ void rot4(f32x4& v0, f32x4& v1, const f32x2* tb, float sc) {
        const f32x4 t0 = *(const f32x4*)tb, t1 = *(const f32x4*)(tb + 2);
        f32x4 a, b;
        a.x = v0.x * t0.x - v0.y * t0.y; a.y = v0.x * t0.y + v0.y * t0.x; a.z = v0.z * t0.z - v0.w * t0.w; a.w = v0.z * t0.w + v0.w * t0.z;
        b.x = v1.x * t1.x - v1.y * t1.y; b.y = v1.x * t1.y + v1.y * t1.x; b.z = v1.z * t1.z - v1.w * t1.w; b.w = v1.z * t1.w + v1.w * t1.z;
        v0 = a * sc; v1 = b * sc;
    }
    static __device__ __forceinline__ void rot4r(f32x4& v0, f32x4& v1, const f32x4 t0, const f32x4 t1, float sc) {
        f32x4 a, b;
        a.x = v0.x * t0.x - v0.y * t0.y; a.y = v0.x * t0.y + v0.y * t0.x; a.z = v0.z * t0.z - v0.w * t0.w; a.w = v0.z * t0.w + v0.w * t0.z;
        b.x = v1.x * t1.x - v1.y * t1.y; b.y = v1.x * t1.y + v1.y * t1.x; b.z = v1.z * t1.z - v1.w * t1.w; b.w = v1.z * t1.w + v1.w * t1.z;
        v0 = a * sc; v1 = b * sc;
    }
    template <int KIND, int RS>
    static __device__ __forceinline__ void run(AccRef acc, bf16_t* base0, bf16_t* base1, const f32x4 (&T0)[4], const f32x4 (&T1)[4], bool usep, float sc, unsigned* w0, unsigned* w1) {
        float mxv[2] = {0.f, 0.f};
#pragma unroll
        for (int ai = 0; ai < 2; ++ai) {
            float sq[2][4];
#pragma unroll
            for (int m = 0; m < 4; ++m) {
                f32x4 t0 = T0[0], t1 = T1[0];
                if (KIND != 2) {
#pragma unroll
                    for (int e = 0; e < 4; ++e) { t0[e] = usep ? T0[ai][e] : T0[m][e]; t1[e] = usep ? T1[ai][e] : T1[m][e]; } }
#pragma unroll
                for (int bj = 0; bj < 2; ++bj) {
                    const bool rot = KIND == 0 || (KIND == 1 && bj == 0);
                    f32x4 v0 = acc[ai][bj][m][0], v1 = acc[ai][bj][m][1];
                    if (rot) rot4r(v0, v1, t0, t1, sc);
                    u32x4 w; w.x = pg8::cvt_pk_bf16(v0.x, v0.y); w.y = pg8::cvt_pk_bf16(v0.z, v0.w); w.z = pg8::cvt_pk_bf16(v1.x, v1.y); w.w = pg8::cvt_pk_bf16(v1.z, v1.w);
                    if (EPIPROJ_WT) st_wt16((bj ? base1 : base0) + (size_t)(ai * 128 + m * 16) * RS, w); else *(u32x4*)((bj ? base1 : base0) + (size_t)(ai * 128 + m * 16) * RS) = w;
#if PROBE_ST2
                    asm volatile("" : "+v"(w) :: "memory"); *(u32x4*)((bj ? base1 : base0) + (size_t)(ai * 128 + m * 16) * RS) = w;
#endif
                    if (rot) sq[bj][m] = (v0.x * v0.x + v0.y * v0.y) + (v0.z * v0.z + v0.w * v0.w) + (v1.x * v1.x + v1.y * v1.y) + (v1.z * v1.z + v1.w * v1.w);
                }
                __builtin_amdgcn_sched_barrier(0);
            }
#pragma unroll
            for (int bj = 0; bj < 2; ++bj) if (KIND == 0 || (KIND == 1 && bj == 0))
                mxv[bj] = fmaxf(mxv[bj], swap32_add(swap16_add(sq[bj][0], sq[bj][1]), swap16_add(sq[bj][2], sq[bj][3])));
            __builtin_amdgcn_sched_barrier(0);
        }
#pragma unroll
        for (int bj = 0; bj < 2; ++bj) if (KIND == 0 || (KIND == 1 && bj == 0)) {
            float mw = mxv[bj];
#pragma unroll
            for (int o = 1; o < 64; o <<= 1) mw = fmaxf(mw, __shfl_xor(mw, o));
            if ((threadIdx.x & 63) == 0) atomicMax(bj ? w1 : w0, __float_as_uint(mw)); }
    }
    __device__ __forceinline__ void operator()(AccRef acc, const pg8::Unit& u, int wr, int wc, int fr_in, int fq_in) const {
        int fr = fr_in, fq = fq_in; asm volatile("" : "+v"(fr), "+v"(fq));
        const int pn = u.pn, b = u.pm >> 6, tl0 = (u.pm & 63) * 256, hw = wc >> 1, wl = wc & 1;
        constexpr float QSA = 0.125f * LOG2E, QSC = 0.17677669529663687f * LOG2E;
        const int pos0 = CTX + tl0 + wr * 64 + fr, dc = wl * 32 + fq * 8;
        const bool ropeA = pn <= 2, ropeC = (pn == 5) || (pn == 6);
        const bool usep = ropeA ? (wl == 0) : (fq < 2);
        f32x4 T0[4], T1[4];
        { const f32x2* tb = ropeA ? tabA : tabC; const int strd = ropeA ? 16 : 8, col = ropeA ? 4 * fq : 4 * (fq & 1);
          const int prow0 = (tl0 >> 6) + wr;
#pragma unroll
          for (int sl = 0; sl < 4; ++sl) { const int row = usep ? prow0 + 2 * (sl & 1) : 16 * sl + fr; const f32x2* e = tb + (size_t)row * strd + col;
              if (ropeA || ropeC) { T0[sl] = *(const f32x4*)e; T1[sl] = *(const f32x4*)(e + 2); } else { T0[sl] = (f32x4){1.f, 0.f, 1.f, 0.f}; T1[sl] = T0[sl]; } } }
        if (pn <= 1) {
            bf16_t* q = (bf16_t*)(r1 + R1_QA); unsigned* w = bnd + 32 + b * 16 + (pn * 4 + hw) * 2 + wl;
            run<0, 64>(acc, q + (((size_t)(b * 8 + pn * 4 + hw) * KEYS + pos0) * 64 + dc), q + (((size_t)(b * 8 + pn * 4 + 2 + hw) * KEYS + pos0) * 64 + dc), T0, T1, usep, QSA, w, w + 4);
        } else if (pn == 2) {
            const size_t o = ((size_t)(b * 2 + hw) * KEYS + pos0) * 64 + dc;
            run<1, 64>(acc, (bf16_t*)(r1 + R1_KA) + o, (bf16_t*)(r1 + R1_VA) + o, T0, T1, usep, 1.f, bnd + 64 + b * 4 + hw * 2 + wl, nullptr);
        } else if (pn == 5 || pn == 6) {
            bf16_t* q = (bf16_t*)(r1 + (pn == 5 ? R1_QC : R1_KC)); unsigned* w = bnd + (pn == 5 ? 0 : 16) + b * 8 + hw * 2 + wl;
            run<0, 64>(acc, q + (((size_t)(b * 4 + hw) * KEYS + pos0) * 64 + dc), q + (((size_t)(b * 4 + 2 + hw) * KEYS + pos0) * 64 + dc), T0, T1, usep, pn == 5 ? QSC : 1.f, w, w + 4);
        } else if (pn == 7) {
            bf16_t* q = (bf16_t*)(r1 + R1_VC);
            run<2, 64>(acc, q + (((size_t)(b * 4 + hw) * KEYS + pos0) * 64 + dc), q + (((size_t)(b * 4 + 2 + hw) * KEYS + pos0) * 64 + dc), T0, T1, usep, 1.f, nullptr, nullptr);
        } else {
            bf16_t* q = (bf16_t*)(r1 + (pn == 3 ? R1_BU : R1_BV)) + (size_t)(u.pm * 256 + wr * 64 + fr) * 256 + wc * 32 + fq * 8;
            run<2, 256>(acc, q, q + 128, T0, T1, usep, 1.f, nullptr, nullptr);
        }
    }
};

struct EpiOut {
    static constexpr bool PERM = true, AFTER_DRAIN = false, IDEM = true;
    __device__ __forceinline__ bool can_repeat() const { return xin != nullptr; }
    const float* xin;
    bf16_t* xs; const float* modl;
    template <bool F32SRC>
    __device__ __forceinline__ void body(AccRef acc, const pg8::Unit& u, int wr, int wc, int fr, int fq) const {
        const int r0 = u.pm * 256, w = r0 >> 14, cb = u.pn * 256 + wc * 32 + fq * 8;
        const float* gt = modl + (size_t)w * 6144 + 2 * D;
        f32x4 g[2][2];
#pragma unroll
        for (int bj = 0; bj < 2; ++bj)
#pragma unroll
            for (int n = 0; n < 2; ++n) g[bj][n] = *(const f32x4*)(gt + cb + bj * 128 + 4 * n);
        const size_t ro0 = (size_t)(r0 + wr * 64 + fr) * D + cb;
        if (F32SRC) {
#pragma unroll
            for (int ai = 0; ai < 2; ++ai) { f32x4 xv[4][2][2];
#pragma unroll
                for (int m = 0; m < 4; ++m)
#pragma unroll
                    for (int bj = 0; bj < 2; ++bj) { const float* p = xin + ro0 + (size_t)(ai * 128 + m * 16) * D + bj * 128; xv[m][bj][0] = *(const f32x4*)p; xv[m][bj][1] = *(const f32x4*)(p + 4); }
                asm volatile("" ::: "memory");
#pragma unroll
                for (int m = 0; m < 4; ++m)
#pragma unroll
                    for (int bj = 0; bj < 2; ++bj) { const f32x4 x0 = xv[m][bj][0] + g[bj][0] * acc[ai][bj][m][0], x1 = xv[m][bj][1] + g[bj][1] * acc[ai][bj][m][1];
                        u32x4 o; o.x = cvt_pk_f16(x0.x, x0.y); o.y = cvt_pk_f16(x0.z, x0.w); o.z = cvt_pk_f16(x1.x, x1.y); o.w = cvt_pk_f16(x1.z, x1.w);
                        *(u32x4*)(xs + ro0 + (size_t)(ai * 128 + m * 16) * D + bj * 128) = o; }
                asm volatile("" ::: "memory"); }
        } else {
            u32x4 xb[2][4][2];
#pragma unroll
            for (int ai = 0; ai < 2; ++ai)
#pragma unroll
                for (int m = 0; m < 4; ++m)
#pragma unroll
                    for (int bj = 0; bj < 2; ++bj) xb[ai][m][bj] = *(const u32x4*)(xs + ro0 + (size_t)(ai * 128 + m * 16) * D + bj * 128);
            asm volatile("" ::: "memory");
#pragma unroll
            for (int ai = 0; ai < 2; ++ai)
#pragma unroll
                for (int m = 0; m < 4; ++m)
#pragma unroll
                    for (int bj = 0; bj < 2; ++bj) { const u32x4 q = xb[ai][m][bj];
                        const f32x4 x0 = (f32x4){hflo(q.x), hfhi(q.x), hflo(q.y), hfhi(q.y)} + g[bj][0] * acc[ai][bj][m][0], x1 = (f32x4){hflo(q.z), hfhi(q.z), hflo(q.w), hfhi(q.w)} + g[bj][1] * acc[ai][bj][m][1];
                        u32x4 o; o.x = cvt_pk_f16(x0.x, x0.y); o.y = cvt_pk_f16(x0.z, x0.w); o.z = cvt_pk_f16(x1.x, x1.y); o.w = cvt_pk_f16(x1.z, x1.w);
                        *(u32x4*)(xs + ro0 + (size_t)(ai * 128 + m * 16) * D + bj * 128) = o; }
        }
    }
    __device__ __forceinline__ void operator()(AccRef acc, const pg8::Unit& u, int wr, int wc, int fr_in, int fq_in) const {
        int fr = fr_in, fq = fq_in; asm volatile("" : "+v"(fr), "+v"(fq));
        if (xin) body<true>(acc, u, wr, wc, fr, fq); else body<false>(acc, u, wr, wc, fr, fq);
    }
};

struct EpiMoe1 {
    static constexpr bool PERM = true, AFTER_DRAIN = false, IDEM = true;
    __device__ __forceinline__ bool can_repeat() const { return true; }
    bf16_t* HE;
    __device__ __forceinline__ void operator()(AccRef acc, const pg8::Unit& u, int wr, int wc, int fr_in, int fq_in) const {
        int fr = fr_in, fq = fq_in; asm volatile("" : "+v"(fr), "+v"(fq));
#pragma unroll
        for (int ai = 0; ai < 2; ++ai)
#pragma unroll
            for (int m = 0; m < 4; ++m) { const int r = u.pm * 256 + ai * 128 + wr * 64 + m * 16 + fr;
                const f32x4 g0 = acc[ai][0][m][0], g1 = acc[ai][0][m][1], u0 = acc[ai][1][m][0], u1 = acc[ai][1][m][1];
                u32x4 w; w.x = pg8::cvt_pk_bf16(silu_f(g0.x) * u0.x, silu_f(g0.y) * u0.y); w.y = pg8::cvt_pk_bf16(silu_f(g0.z) * u0.z, silu_f(g0.w) * u0.w);
                w.z = pg8::cvt_pk_bf16(silu_f(g1.x) * u1.x, silu_f(g1.y) * u1.y); w.w = pg8::cvt_pk_bf16(silu_f(g1.z) * u1.z, silu_f(g1.w) * u1.w);
                st_wt16(HE + (size_t)r * DEXP + u.pn * 128 + wc * 32 + fq * 8, w); }
    }
};
struct EpiMoe2 {
    static constexpr bool PERM = true, AFTER_DRAIN = false, IDEM = true;
    __device__ __forceinline__ bool can_repeat() const { return true; }
    bf16_t* YE; const int* rowmap; const float* wslot;
    __device__ __forceinline__ void operator()(AccRef acc, const pg8::Unit& u, int wr, int wc, int fr_in, int fq_in) const {
        int fr = fr_in, fq = fq_in; asm volatile("" : "+v"(fr), "+v"(fq));
        int drs[2][4]; float wss[2][4];
#pragma unroll
        for (int ai = 0; ai < 2; ++ai)
#pragma unroll
            for (int m = 0; m < 4; ++m) { const int r = u.pm * 256 + ai * 128 + wr * 64 + m * 16 + fr; drs[ai][m] = rowmap[r]; wss[ai][m] = wslot[r]; }
        asm volatile("" ::: "memory");
#pragma unroll
        for (int ai = 0; ai < 2; ++ai)
#pragma unroll
            for (int m = 0; m < 4; ++m) { const int dr = drs[ai][m]; const float ws = wss[ai][m];
                if (dr >= 0) {
#pragma unroll
                    for (int bj = 0; bj < 2; ++bj) { const f32x4 a = acc[ai][bj][m][0] * ws, b = acc[ai][bj][m][1] * ws;
                        u32x4 w; w.x = pg8::cvt_pk_bf16(a.x, a.y); w.y = pg8::cvt_pk_bf16(a.z, a.w); w.z = pg8::cvt_pk_bf16(b.x, b.y); w.w = pg8::cvt_pk_bf16(b.z, b.w);
                        *(u32x4*)(YE + (size_t)dr * D + u.pn * 256 + bj * 128 + wc * 32 + fq * 8) = w; } } }
    }
};
struct OneUnit { int pm, pn;
    __device__ __forceinline__ bool next(int i, pg8::Unit& u) const { if (i > 0) return false; u.pm = pm; u.pn = pn; u.be = 0; return true; }
    __device__ __forceinline__ void a_ready(const pg8::Unit&) const {}
    __device__ __forceinline__ void done(const pg8::Unit&) const {}
};
struct GroupedOrder {
    int nN, G, c, total; const LAS int* tbase; unsigned* cnt;
    __device__ __forceinline__ bool next(int i, pg8::Unit& u) const {
        int L;
        if (G == 256 && nN == 4) { const int x = c & 7, y = c >> 3; L = (i * 64 + x * 8 + (y >> 2)) * 4 + (y & 3); } else L = i * G + c;
        if (L >= total) return false;
        const int pm = L / nN, pn = L - pm * nN; int e = 0;
#pragma unroll
        for (int k = 1; k < NEXP; ++k) e += (pm >= tbase[k]) ? 1 : 0;
        u.pm = __builtin_amdgcn_readfirstlane(pm); u.pn = __builtin_amdgcn_readfirstlane(pn); u.be = __builtin_amdgcn_readfirstlane(e); return true;
    }
    __device__ __forceinline__ void a_ready(const pg8::Unit&) const {}
    __device__ __forceinline__ void done(const pg8::Unit& u) const {
        if (cnt) { asm volatile("s_waitcnt vmcnt(0)" ::: "memory");
            if ((threadIdx.x & 63) == 0) __hip_atomic_fetch_add(cnt + 16 * u.pm, 1u, __ATOMIC_RELAXED, __HIP_MEMORY_SCOPE_AGENT); } }
};
struct GroupedOrder2 {
    int G, c, total; const LAS int* tbase; unsigned* cnt;
    __device__ __forceinline__ bool next(int i, pg8::Unit& u) const {
        int L;
        const int rf = total / 256, rem = total - rf * 256, nl = 256 - rem;
        if (G == 256 && rf >= 1 && 2 * rem <= nl) { const int x = c & 7, y = c >> 3, rho = 255 - ((x * 8 + (y >> 2)) * 4 + (y & 3));
            if (i < rf - 1) L = i * 256 + rho;
            else { const int e = i - (rf - 1); if (rho >= nl) return false; L = (rf - 1) * 256 + e * nl + rho; } }
        else L = i * G + (G - 1 - c);
        if (L >= total) return false;
        const int pm = L >> 2, pn = L & 3; int e = 0;
#pragma unroll
        for (int k = 1; k < NEXP; ++k) e += (pm >= tbase[k]) ? 1 : 0;
        u.pm = __builtin_amdgcn_readfirstlane(pm); u.pn = __builtin_amdgcn_readfirstlane(pn); u.be = __builtin_amdgcn_readfirstlane(e); return true;
    }
    __device__ __forceinline__ void a_ready(const pg8::Unit& u) const {
        if (__builtin_amdgcn_readfirstlane((int)(threadIdx.x >> 6)) == 0) { unsigned sp = 0;
            while (__hip_atomic_load(cnt + 16 * u.pm, __ATOMIC_RELAXED, __HIP_MEMORY_SCOPE_AGENT) < 32u) { __builtin_amdgcn_s_sleep(2); if (++sp > (1u << 24)) break; }
            __builtin_amdgcn_fence(__ATOMIC_ACQUIRE, "agent"); asm volatile("s_waitcnt vmcnt(0) lgkmcnt(0)" ::: "memory"); }
        asm volatile("" ::: "memory"); __builtin_amdgcn_s_barrier(); asm volatile("" ::: "memory");
    }
    __device__ __forceinline__ void done(const pg8::Unit&) const {}
};
__device__ __forceinline__ void load_tile_bases(Frame& F, int l, LAS int* tb) {
    if (F.tid == 0) { const int* cnt = (const int*)(F.ws + WS_CNT) + l * NEXP; int acc = 0;
        for (int e = 0; e < NEXP; ++e) { tb[e] = acc; acc += (cnt[e] + 255) >> 8; } tb[NEXP] = acc; }
    __syncthreads();
}


typedef float f32x4_t __attribute__((ext_vector_type(4)));
template <class Epi>
__device__ __forceinline__ void ctx_gemm(Frame& F, const bf16_t* H  , const bf16_t* Wt  , int N, const Epi& E) {
    int tid_l = threadIdx.x; asm volatile("" : "+v"(tid_l));
    const int lane = tid_l & 63, wv = __builtin_amdgcn_readfirstlane(tid_l >> 6), tok = lane & 15, g = lane >> 4;
    const int ncb = N / 32, ntiles = (NCTX / 16) * ncb;
    for (int wt = F.bid * NWAVES + wv; wt < ntiles; wt += F.G * NWAVES) {
        const int tm = wt / ncb, c0 = (wt - tm * ncb) * 32;
        const bf16_t* hp = H + (size_t)(tm * 16 + tok) * D + 8 * g;
        const bf16_t* wp = Wt + (size_t)(c0 + tok) * D + 8 * g;
        f32x4_t acc0 = {0.f, 0.f, 0.f, 0.f}, acc1 = {0.f, 0.f, 0.f, 0.f};
#pragma unroll 8
        for (int ks = 0; ks < D / 32; ++ks) { const bf16x8 hf = *(const bf16x8*)(hp + ks * 32), w0 = *(const bf16x8*)(wp + ks * 32), w1 = *(const bf16x8*)(wp + (size_t)16 * D + ks * 32);
            acc0 = __builtin_amdgcn_mfma_f32_16x16x32_bf16(w0, hf, acc0, 0, 0, 0); acc1 = __builtin_amdgcn_mfma_f32_16x16x32_bf16(w1, hf, acc1, 0, 0, 0); }
        E(tm * 16 + tok, c0, g, acc0, acc1);
    }
}
struct CtxEpiProj {
    unsigned char* r1; unsigned* bnd;
    __device__ __forceinline__ void operator()(int rc, int c0, int g, f32x4_t a0, f32x4_t a1) const {
        constexpr float QSA = 0.125f * LOG2E, QSC = 0.17677669529663687f * LOG2E;
        const int b = rc >> 8, pos = rc & 255, r = NLAT + rc, pn = c0 >> 8, cc0 = c0 & 255;
        float sc = 1.f; if (pn <= 1) sc = QSA; else if (pn == 5) sc = QSC;
        a0 = a0 * sc; a1 = a1 * sc;
        const bool track = (pn <= 1) || (pn == 2 && cc0 < 128) || pn == 5 || pn == 6;
#pragma unroll
        for (int cb = 0; cb < 2; ++cb) { const f32x4_t v = cb ? a1 : a0; const int cc = cc0 + 16 * cb + 4 * g; bf16_t* dst;
            if (pn <= 1) dst = (bf16_t*)(r1 + R1_QA) + (((size_t)(b * 8 + pn * 4 + (cc >> 6)) * KEYS + pos) * 64 + (cc & 63));
            else if (pn == 2) dst = (bf16_t*)(r1 + (cc < 128 ? R1_KA : R1_VA)) + (((size_t)(b * 2 + ((cc & 127) >> 6)) * KEYS + pos) * 64 + (cc & 63));
            else if (pn == 3) dst = (bf16_t*)(r1 + R1_BU) + ((size_t)r * 256 + cc);
            else if (pn == 4) dst = (bf16_t*)(r1 + R1_BV) + ((size_t)r * 256 + cc);
            else dst = (bf16_t*)(r1 + (pn == 5 ? R1_QC : (pn == 6 ? R1_KC : R1_VC))) + (((size_t)(b * 4 + (cc >> 6)) * KEYS + pos) * 64 + (cc & 63));
            *(u32x2*)dst = (u32x2){pg8::cvt_pk_bf16(v.x, v.y), pg8::cvt_pk_bf16(v.z, v.w)}; }
        if (track) {
            float ss = (a0.x * a0.x + a0.y * a0.y) + (a0.z * a0.z + a0.w * a0.w) + (a1.x * a1.x + a1.y * a1.y) + (a1.z * a1.z + a1.w * a1.w);
            ss = swap16_add(ss, ss); ss = swap32_add(ss, ss);
            float m = ss; m = fmaxf(m, __shfl_xor(m, 1)); m = fmaxf(m, __shfl_xor(m, 2)); m = fmaxf(m, __shfl_xor(m, 4)); m = fmaxf(m, __shfl_xor(m, 8));
            const int half = (cc0 >> 5) & 1; int word;
            if (pn <= 1) word = 32 + b * 16 + (pn * 4 + (cc0 >> 6)) * 2 + half;
            else if (pn == 2) word = 64 + b * 4 + (cc0 >> 6) * 2 + half;
            else word = (pn == 5 ? 0 : 16) + b * 8 + (cc0 >> 6) * 2 + half;
            if ((threadIdx.x & 63) == 0) atomicMax(bnd + word, __float_as_uint(m)); }
    }
};
struct CtxEpiOut {
    const float* src; bf16_t* dst; const float* gt;
    __device__ __forceinline__ void operator()(int rc, int c0, int g, f32x4_t a0, f32x4_t a1) const {
#pragma unroll
        for (int cb = 0; cb < 2; ++cb) { const int c = c0 + 16 * cb + 4 * g; const f32x4_t v = cb ? a1 : a0;
            const f32x4_t x = *(const f32x4_t*)(src + (size_t)rc * D + c), gg = *(const f32x4_t*)(gt + c);
            const f32x4_t y = x + gg * v;
            *(u32x2*)(dst + (size_t)rc * D + c) = (u32x2){cvt_pk_f16(y[0], y[1]), cvt_pk_f16(y[2], y[3])}; }
    }
};

struct ModCache { int w; f32x4 A[4], B[4]; };
__device__ __forceinline__ void route_group(Frame& F, int l, LAS float* RW, LAS int* hist, f32x4 (&v)[4][4], int rb, int nr, ModCache& mc) {
    bf16_t* H2 = (bf16_t*)(F.ws + WS_R1 + R1_H2);
    const int trow = F.lane >> 4;
    float ss[4];
#pragma unroll
    for (int t = 0; t < 4; ++t) { float s = 0.f;
#pragma unroll
        for (int j = 0; j < 4; ++j) s += (v[t][j].x * v[t][j].x + v[t][j].y * v[t][j].y) + (v[t][j].z * v[t][j].z + v[t][j].w * v[t][j].w);
        ss[t] = s; }
#pragma unroll
    for (int t = 0; t < 4; ++t) ss[t] = wave_sum(ss[t]);
#pragma unroll
    for (int t = 0; t < 4; ++t) { const int r = rb + (t < nr ? t : 0), w = mod_w(r); const float rinv = 1.0f / sqrtf(ss[t] * (1.f / D) + EPS);
        if (w != mc.w) { mc.w = w;
            const f32x4* g = (const f32x4*)(INP(I_GFFN) + l * D) + F.lane; const f32x4* sh = (const f32x4*)mod_ptr(F, l, w, 3) + F.lane; const f32x4* sc = (const f32x4*)mod_ptr(F, l, w, 4) + F.lane;
#pragma unroll
            for (int j = 0; j < 4; ++j) { mc.A[j] = g[64 * j] * (1.f + sc[64 * j]); mc.B[j] = sh[64 * j]; } }
        u32x2* o = (u32x2*)(H2 + (size_t)r * D) + F.lane;
#pragma unroll
        for (int j = 0; j < 4; ++j) { const f32x4 h = v[t][j] * (mc.A[j] * rinv) + mc.B[j]; v[t][j] = h; if (t < nr) o[64 * j] = (u32x2){pk2(h.x, h.y), pk2(h.z, h.w)}; } }
    float lg[4][4];
#pragma unroll
    for (int t = 0; t < 4; ++t)
#pragma unroll
        for (int c = 0; c < 4; ++c) lg[t][c] = 0.f;
#pragma unroll
    for (int j = 0; j < 4; ++j)
#pragma unroll
        for (int i = 0; i < 4; ++i) { const f32x4 wq = *(const LAS f32x4*)(RW + (size_t)((j * 4 + i) * 64 + F.lane) * 20);
#pragma unroll
            for (int t = 0; t < 4; ++t) { const float hv = v[t][j][i]; lg[t][0] += hv * wq.x; lg[t][1] += hv * wq.y; lg[t][2] += hv * wq.z; lg[t][3] += hv * wq.w; } }
    const float* brg = INP(I_BRG) + l * 4; const float* bre = INP(I_BRE) + l * 16;
    float gl[4];
#pragma unroll
    for (int c = 0; c < 4; ++c) { const float w0 = swap32_add(lg[0][c], lg[2][c]), w1 = swap32_add(lg[1][c], lg[3][c]); gl[c] = row16_sum(swap16_add(w0, w1)) + brg[c]; }
    int gsel = 0; float gm = gl[0];
#pragma unroll
    for (int c = 1; c < 4; ++c) if (gl[c] > gm) { gm = gl[c]; gsel = c; }
    float gs = 0.f;
#pragma unroll
    for (int c = 0; c < 4; ++c) gs += __expf(gl[c] - gm);
    const float ptop = 1.f / gs;
    int gr[4];
#pragma unroll
    for (int t = 0; t < 4; ++t) gr[t] = __builtin_amdgcn_readlane(gsel, 16 * t);
    float lx[4][4];
#pragma unroll
    for (int t = 0; t < 4; ++t)
#pragma unroll
        for (int c = 0; c < 4; ++c) lx[t][c] = 0.f;
#pragma unroll
    for (int j = 0; j < 4; ++j)
#pragma unroll
        for (int i = 0; i < 4; ++i) { const LAS float* rwb = RW + (size_t)((j * 4 + i) * 64 + F.lane) * 20 + 4;
#pragma unroll
            for (int t = 0; t < 4; ++t) { const f32x4 wq = *(const LAS f32x4*)(rwb + 4 * gr[t]); const float hv = v[t][j][i];
                lx[t][0] += hv * wq.x; lx[t][1] += hv * wq.y; lx[t][2] += hv * wq.z; lx[t][3] += hv * wq.w; } }
    float le[4];
#pragma unroll
    for (int c = 0; c < 4; ++c) { const float w0 = swap32_add(lx[0][c], lx[2][c]), w1 = swap32_add(lx[1][c], lx[3][c]); le[c] = row16_sum(swap16_add(w0, w1)) + bre[4 * gsel + c]; }
    int i0 = 0; float m0 = le[0];
#pragma unroll
    for (int j = 1; j < 4; ++j) if (le[j] > m0) { m0 = le[j]; i0 = j; }
    int i1 = -1; float m1 = -3.4e38f;
#pragma unroll
    for (int j = 0; j < 4; ++j) if (j != i0 && le[j] > m1) { m1 = le[j]; i1 = j; }
    const float ex = __expf(m1 - m0), w0 = ptop / (1.f + ex), w1 = ptop * ex / (1.f + ex);
    const int e0 = gsel * 4 + i0, e1 = gsel * 4 + i1;
    if ((F.lane & 15) == 0 && trow < nr) { int* ro = (int*)(F.ws + WS_ROUTE) + (size_t)(rb + trow) * 4; ro[0] = e0; ro[1] = e1; ((float*)ro)[2] = w0; ((float*)ro)[3] = w1;
        atomicAdd((int*)hist + e0, 1); atomicAdd((int*)hist + e1, 1); }
}
__device__ __forceinline__ void route_phase(Frame& F, int l, int M) {
    LAS float* RW = (LAS float*)F.lds;
    LAS int* hist = (LAS int*)(F.lds + 81920);
    { const float* wrg = INP(I_WRG) + (size_t)l * D * 4; const float* wre = INP(I_WRE) + (size_t)l * D * 16;
#pragma unroll
      for (int m = 0; m < 2; ++m) { const int c = F.tid + NTHR * m; const int slot = ((c >> 8) * 4 + (c & 3)) * 64 + ((c >> 2) & 63);
          LAS f32x4* d = (LAS f32x4*)(RW + slot * 20); d[0] = *(const f32x4*)(wrg + c * 4);
#pragma unroll
          for (int q = 0; q < 4; ++q) d[1 + q] = *(const f32x4*)(wre + c * 16 + 4 * q); } }
    if (F.tid < NEXP) hist[F.tid] = 0;
    __syncthreads();
    const int RPW = (M + F.G - 1) / F.G, r0 = F.bid * RPW, nrows = max(0, min(RPW, M - r0));
#define RT_LOAD(V, gq_) do { const int rb_ = r0 + (gq_) * 4, nr_ = min(4, nrows - (gq_) * 4); \
        _Pragma("unroll") for (int t = 0; t < 4; ++t) { const u32x2* s_ = (const u32x2*)xs_row(F, rb_ + (t < nr_ ? t : 0)) + F.lane; \
            _Pragma("unroll") for (int j = 0; j < 4; ++j) V[t][j] = s_[64 * j]; } } while (0)
#define RT_EXPAND(V) do { _Pragma("unroll") for (int t = 0; t < 4; ++t) _Pragma("unroll") for (int j = 0; j < 4; ++j) vx[t][j] = (f32x4){hflo(V[t][j].x), hfhi(V[t][j].x), hflo(V[t][j].y), hfhi(V[t][j].y)}; } while (0)
    u32x2 vA[4][4], vB[4][4]; f32x4 vx[4][4]; ModCache mc; mc.w = -1;
    int gq = F.wave;
    if (gq * 4 < nrows) RT_LOAD(vA, gq);
    while (gq * 4 < nrows) {
        const bool h1 = (gq + NWAVES) * 4 < nrows;
        if (h1) RT_LOAD(vB, gq + NWAVES);
        RT_EXPAND(vA); route_group(F, l, RW, hist, vx, r0 + gq * 4, min(4, nrows - gq * 4), mc);
        gq += NWAVES; if (!h1) break;
        const bool h2 = (gq + NWAVES) * 4 < nrows;
        if (h2) RT_LOAD(vA, gq + NWAVES);
        RT_EXPAND(vB); route_group(F, l, RW, hist, vx, r0 + gq * 4, min(4, nrows - gq * 4), mc);
        gq += NWAVES; if (!h2) break;
    }
#undef RT_LOAD
#undef RT_EXPAND
    __syncthreads();
    if (F.tid < NEXP) ((int*)(F.ws + WS_HIST))[(size_t)(l * 256 + F.bid) * NEXP + F.tid] = hist[F.tid];
}

__device__ __forceinline__ void permute_phase(Frame& F, int l, int M) {
    LAS int* cnt = (LAS int*)F.lds; LAS int* base = cnt + 16; LAS int* wgoff = base + 32; LAS int* eids = wgoff + 16; LAS int* slots = eids + 1024;
    const int* HIST = (const int*)(F.ws + WS_HIST) + (size_t)l * 256 * NEXP;
    const int RPW = (M + F.G - 1) / F.G, r0 = F.bid * RPW, nrows = max(0, min(RPW, M - r0)), nitems = 2 * nrows;
    const int* ROUTE = (const int*)(F.ws + WS_ROUTE);
    if (F.tid < NEXP) { int tot = 0, before = 0; for (int g = 0; g < F.G; ++g) { const int h = HIST[g * NEXP + F.tid]; tot += h; before += (g < F.bid) ? h : 0; } cnt[F.tid] = tot; wgoff[F.tid] = before; }
    for (int i = F.tid; i < nitems; i += NTHR) eids[i] = ROUTE[(size_t)(r0 + (i >> 1)) * 4 + (i & 1)];
    __syncthreads();
    if (F.tid == 0) { int acc = 0; for (int e = 0; e < NEXP; ++e) { base[e] = acc; acc += (cnt[e] + 255) & ~255; } base[NEXP] = acc;
        if (F.bid == 0) { int* c = (int*)(F.ws + WS_CNT) + l * NEXP; for (int e = 0; e < NEXP; ++e) c[e] = cnt[e]; } }
    __syncthreads();
    for (int e = F.wave * 2; e < F.wave * 2 + 2; ++e) { int running = base[e] + wgoff[e];
        for (int c0 = 0; c0 < nitems; c0 += 64) { const int i = c0 + F.lane; const bool mt = (i < nitems) && (eids[i] == e);
            const unsigned long long bal = __ballot(mt); const int rank = __popcll(bal & ((1ull << F.lane) - 1ull));
            if (mt) slots[i] = running + rank; running += __popcll(bal); } }
    __syncthreads();
    int* ROWMAP = (int*)(F.ws + WS_ROWMAP); float* WSLOT = (float*)(F.ws + WS_WSLOT);
    for (int i = F.tid; i < nitems; i += NTHR) { const int slot = slots[i], r = r0 + (i >> 1), k = i & 1;
        ROWMAP[slot] = 2 * r + k; WSLOT[slot] = ((const float*)ROUTE)[(size_t)r * 4 + 2 + k]; }
    const int gt = F.bid * NTHR + F.tid, NGT = F.G * NTHR;
    for (int e = 0; e < NEXP; ++e) { const int p0 = base[e] + cnt[e], np = base[e + 1] - p0;
        for (int p = gt; p < np; p += NGT) { ROWMAP[p0 + p] = -1; WSLOT[p0 + p] = 0.f; } }
}

__device__ __forceinline__ int crow(int r, int hi) { return (r & 3) + 8 * (r >> 2) + 4 * hi; }
typedef short v4i16_t __attribute__((ext_vector_type(4)));
__device__ __forceinline__ s16x4 vtr(const LAS unsigned char* p) { return __builtin_bit_cast(s16x4, __builtin_amdgcn_ds_read_tr16_b64_v4i16((LAS v4i16_t*)p)); }

template <int NMAP>
__device__ __forceinline__ void attn_unit(LAS unsigned char* lds, const bf16_t* qw, const bf16_t* Kb, const bf16_t* Vb, int ta_lo, int ta_n, int tb_lo, int tb_n,
                                          int qlat, float m_init, float l_init, f32x16 (&o)[NMAP][2], float (&lsum)[NMAP]) {
    int tid_l = threadIdx.x; asm volatile("" : "+v"(tid_l));
    const int tid = tid_l, lane = tid & 63, r32 = lane & 31, hi = lane >> 5;
    const int skey = tid >> 3, sch = tid & 7;
    const int kst = skey * 128 + ((sch ^ ((skey >> 1) & 7)) << 4);
    const int vst = 16384 + (sch >> 2) * 4096 + (skey >> 4) * 1024 + (skey & 15) * 64 + (sch & 3) * 16;
    const size_t goff = (size_t)skey * 64 + sch * 8;
    const int vrd = 16384 + ((lane >> 4) & 1) * 32 + (lane & 3) * 8 + (4 * hi + ((lane & 15) >> 2)) * 64;
    bf16x8 qr[4];
#pragma unroll
    for (int s = 0; s < 4; ++s) qr[s] = *(const bf16x8*)(qw + (size_t)r32 * 64 + s * 16 + hi * 8);
    float mrun[NMAP];
#pragma unroll
    for (int mp = 0; mp < NMAP; ++mp) { mrun[mp] = m_init; lsum[mp] = l_init; o[mp][0] = f32x16{}; o[mp][1] = f32x16{}; }
    const int ntile = ta_n + tb_n;
    u32x4 kreg, vreg;
    { const int T = (ta_n > 0) ? ta_lo : tb_lo; kreg = *(const u32x4*)(Kb + (size_t)T * 4096 + goff); vreg = *(const u32x4*)(Vb + (size_t)T * 4096 + goff); }
    *(LAS u32x4*)(lds + kst) = kreg; *(LAS u32x4*)(lds + vst) = vreg;
    __syncthreads();
    for (int t = 0; t < ntile; ++t) {
        const int cur = (t & 1) * 8192;
        if (t + 1 < ntile) { const int T = (t + 1 < ta_n) ? ta_lo + t + 1 : tb_lo + (t + 1 - ta_n); kreg = *(const u32x4*)(Kb + (size_t)T * 4096 + goff); vreg = *(const u32x4*)(Vb + (size_t)T * 4096 + goff); }
#pragma unroll
        for (int mp = 0; mp < NMAP; ++mp) {
            f32x16 S[2];
#pragma unroll
            for (int kb = 0; kb < 2; ++kb) { const int key = kb * 32 + r32; const LAS unsigned char* kp = lds + cur + key * 128; const int sw = (key >> 1) & 7;
                f32x16 a = f32x16{};
                constexpr int NS = (NMAP == 1) ? 4 : 2;
#pragma unroll
                for (int s = 0; s < NS; ++s) { const int sq = (NMAP == 1) ? s : 2 * mp + s; const bf16x8 kf = *(const LAS bf16x8*)(kp + (((2 * sq + hi) ^ sw) << 4));
                    a = __builtin_amdgcn_mfma_f32_32x32x16_bf16(kf, qr[sq], a, 0, 0, 0); }
                S[kb] = a; }
            if (NMAP == 1 && qlat >= 0 && t >= ta_n) { const int kl0 = (tb_lo + (t - ta_n) - 4) * 64;
#pragma unroll
                for (int kb = 0; kb < 2; ++kb)
#pragma unroll
                    for (int r = 0; r < 16; ++r) { const int dlt = kl0 + kb * 32 + crow(r, hi) - qlat; if (dlt > 128 || dlt < -128) S[kb][r] = NEGBIG; } }
            float rm = S[0][0];
#pragma unroll
            for (int r = 1; r < 16; ++r) rm = fmaxf(rm, S[0][r]);
#pragma unroll
            for (int r = 0; r < 16; ++r) rm = fmaxf(rm, S[1][r]);
            rm = fmaxf(rm, __shfl_xor(rm, 32));
            if (__any(rm > mrun[mp] + 8.f)) { const float mn = fmaxf(mrun[mp], rm), al = __builtin_amdgcn_exp2f(mrun[mp] - mn); mrun[mp] = mn; lsum[mp] *= al; o[mp][0] = o[mp][0] * al; o[mp][1] = o[mp][1] * al; }
            float ps = 0.f;
#pragma unroll
            for (int kb = 0; kb < 2; ++kb)
#pragma unroll
                for (int r = 0; r < 16; ++r) { const float p = __builtin_amdgcn_exp2f(S[kb][r] - mrun[mp]); S[kb][r] = p; ps += p; }
            lsum[mp] += ps;
#pragma unroll
            for (int kb = 0; kb < 2; ++kb)
#pragma unroll
                for (int s2 = 0; s2 < 2; ++s2) { const int ks = 2 * kb + s2;
                    u32x4 pw; pw.x = pg8::cvt_pk_bf16(S[kb][8 * s2 + 0], S[kb][8 * s2 + 1]); pw.y = pg8::cvt_pk_bf16(S[kb][8 * s2 + 2], S[kb][8 * s2 + 3]);
                    pw.z = pg8::cvt_pk_bf16(S[kb][8 * s2 + 4], S[kb][8 * s2 + 5]); pw.w = pg8::cvt_pk_bf16(S[kb][8 * s2 + 6], S[kb][8 * s2 + 7]);
                    const bf16x8 pf = __builtin_bit_cast(bf16x8, pw);
#pragma unroll
                    for (int d0 = 0; d0 < 2; ++d0) { const s16x4 lo = vtr(lds + cur + vrd + d0 * 4096 + ks * 1024), hh = vtr(lds + cur + vrd + d0 * 4096 + ks * 1024 + 512);
                        const bf16x8 vf = (bf16x8){lo[0], lo[1], lo[2], lo[3], hh[0], hh[1], hh[2], hh[3]};
                        o[mp][d0] = __builtin_amdgcn_mfma_f32_32x32x16_bf16(vf, pf, o[mp][d0], 0, 0, 0); } }
            __builtin_amdgcn_sched_barrier(0);
        }
        if (t + 1 < ntile) { *(LAS u32x4*)(lds + (cur ^ 8192) + kst) = kreg; *(LAS u32x4*)(lds + (cur ^ 8192) + vst) = vreg; }
        __syncthreads();
    }
#pragma unroll
    for (int mp = 0; mp < NMAP; ++mp) lsum[mp] = xor32_sum(lsum[mp]);
}


__device__ __forceinline__ void glds16(const void* gsrc, unsigned lds_dst) { unsigned keep;
    asm volatile("s_mov_b32 %0, m0\n\ts_mov_b32 m0, %2\n\ts_nop 0\n\tglobal_load_lds_dwordx4 %1, off\n\ts_mov_b32 m0, %0" : "=&s"(keep) : "v"(gsrc), "s"(lds_dst) : "memory"); }

__device__ __forceinline__ float dot2_ones(unsigned w, float acc) { const pg8::bf16x2_t one = {(__bf16)1.0f, (__bf16)1.0f}; return __builtin_amdgcn_fdot2_f32_bf16(__builtin_bit_cast(pg8::bf16x2_t, w), one, acc, false); }
#ifndef PROBE_A2
#define PROBE_A2 0
#endif
#ifndef A_LEAD
#define A_LEAD 4
#endif
#ifndef AF_SMPRIO
#define AF_SMPRIO 0
#endif
#ifndef AF_PVPRIO
#define AF_PVPRIO 0
#endif
#ifndef AF_PRIO
#define AF_PRIO 0
#endif
#ifndef PROBE_EXP
#define PROBE_EXP 0
#endif
#ifndef PROBE_MFMA
#define PROBE_MFMA 0
#endif
#ifndef PROBE_NOSTAG
#define PROBE_NOSTAG 0
#endif
#if PROBE_EXP
#define AF_PROBE_EXP(a, b, c, d) do { const float q0_ = __builtin_amdgcn_exp2f((a) * 0.5f), q1_ = __builtin_amdgcn_exp2f((b) * 0.5f), q2_ = __builtin_amdgcn_exp2f((c) * 0.5f), q3_ = __builtin_amdgcn_exp2f((d) * 0.5f); asm volatile("" :: "v"(q0_), "v"(q1_), "v"(q2_), "v"(q3_)); } while (0)
#else
#define AF_PROBE_EXP(a, b, c, d) do {} while (0)
#endif
#if PROBE_MFMA
#define AF_PROBE_MFMA(v0, v1, p) do { dmy = __builtin_amdgcn_mfma_f32_32x32x16_bf16(v0, p, dmy, 0, 0, 0); dmy = __builtin_amdgcn_mfma_f32_32x32x16_bf16(v1, p, dmy, 0, 0, 0); } while (0)
#else
#define AF_PROBE_MFMA(v0, v1, p) do {} while (0)
#endif
template <int NMAP, bool PRE = false, int PRE_ST = 0, int LEAD = 2>
__device__ __forceinline__ void attn_fast(LAS unsigned char* lds, const bf16_t* qw, const bf16_t* Kb, const bf16_t* Vb, int ta_lo, int ta_n, int tb_lo, int tb_n,
                                          int qlat, float l_init, f32x16 (&o)[NMAP][2], float (&lsum)[NMAP], bf16x8 (&qr)[4]) {
    int tid_l = threadIdx.x; asm volatile("" : "+v"(tid_l));
    const int tid = tid_l, lane = tid & 63, r32 = lane & 31, hi = lane >> 5, wid = __builtin_amdgcn_readfirstlane(tid >> 6);
    const bool lead = PROBE_NOSTAG ? true : (wid < 4);
    const int kkey = wid * 8 + (lane >> 3), kc = (lane & 7) ^ ((kkey >> 1) & 7);
    const size_t ksrc = (size_t)kkey * 64 + kc * 8;
    const size_t vsrc = (size_t)(16 * (wid & 3) + (lane >> 2)) * 64 + 32 * (wid >> 2) + (lane & 3) * 8;
    const int vrd = 8192 + ((lane >> 4) & 1) * 32 + (lane & 3) * 8 + (4 * hi + ((lane & 15) >> 2)) * 64;
    const int krd0 = r32 * 128, ksw0 = (r32 >> 1) & 7;
    if (!PRE) {
#pragma unroll
        for (int s = 0; s < 4; ++s) qr[s] = *(const bf16x8*)(qw + (size_t)r32 * 64 + s * 16 + hi * 8); }
    const int ntile = ta_n + tb_n;
#define AF_TILE(t) ((t) < ta_n ? ta_lo + (t) : tb_lo + (t) - ta_n)
#define AF_DMA(t) do { const int T_ = AF_TILE(t); const unsigned so_ = lds0 + (unsigned)(((t) & (2 * LEAD - 1)) * 16384 + wid * 1024); \
        glds16(Kb + (size_t)T_ * 4096 + ksrc, (unsigned)__builtin_amdgcn_readfirstlane(so_)); \
        glds16(Vb + (size_t)T_ * 4096 + vsrc, (unsigned)__builtin_amdgcn_readfirstlane(so_ + 8192u)); } while (0)
    const unsigned lds0 = (unsigned)(uintptr_t)lds;
    static_assert(!PRE || LEAD == 2, "af_begin requests two tiles");
    if (!PRE) { _Pragma("unroll") for (int k = 0; k < LEAD; ++k) if (k < ntile) AF_DMA(k); }
#pragma unroll
    for (int s = 0; s < 4; ++s) asm volatile("" : "+v"(qr[s]));
#pragma unroll
    for (int mp = 0; mp < NMAP; ++mp) { lsum[mp] = l_init; o[mp][0] = f32x16{}; o[mp][1] = f32x16{}; }
    bf16x8 pf[NMAP][4];
    f32x16 dmy = f32x16{};
#define AF_QKSM(sl, t) do { if (AF_SMPRIO) __builtin_amdgcn_s_setprio(1); float ps0[NMAP], ps1[NMAP], ps2[NMAP], ps3[NMAP]; \
        _Pragma("unroll") for (int mp = 0; mp < NMAP; ++mp) { ps0[mp] = 0.f; ps1[mp] = 0.f; ps2[mp] = 0.f; ps3[mp] = 0.f; } \
        _Pragma("unroll") for (int kb = 0; kb < 2; ++kb) { f32x16 S[NMAP]; const LAS unsigned char* kp = lds + (sl) + kb * 4096 + krd0; bf16x8 kf[4]; \
            _Pragma("unroll") for (int s = 0; s < 4; ++s) kf[s] = *(const LAS bf16x8*)(kp + (((2 * s + hi) ^ ksw0) << 4)); \
            if (NMAP == 1) { f32x16 a = f32x16{}; _Pragma("unroll") for (int s = 0; s < 4; ++s) a = __builtin_amdgcn_mfma_f32_32x32x16_bf16(kf[s], qr[s], a, 0, 0, 0); S[0] = a; } \
            else { f32x16 a = f32x16{}, b = f32x16{}; \
                a = __builtin_amdgcn_mfma_f32_32x32x16_bf16(kf[0], qr[0], a, 0, 0, 0); a = __builtin_amdgcn_mfma_f32_32x32x16_bf16(kf[1], qr[1], a, 0, 0, 0); \
                b = __builtin_amdgcn_mfma_f32_32x32x16_bf16(kf[2], qr[2], b, 0, 0, 0); b = __builtin_amdgcn_mfma_f32_32x32x16_bf16(kf[3], qr[3], b, 0, 0, 0); \
                S[0] = a; S[NMAP - 1] = b; } \
            if (NMAP == 1 && qlat >= 0 && (t) >= ta_n) { const int kl0 = (tb_lo + ((t) - ta_n) - 4) * 64; \
                if ((kl0 >> 7) != (__builtin_amdgcn_readfirstlane(qlat) >> 7)) { const int db = kl0 + kb * 32 + 4 * hi - qlat; \
                _Pragma("unroll") for (int r = 0; r < 16; ++r) { const int dlt = db + (r & 3) + 8 * (r >> 2); if (dlt > 128 || dlt < -128) S[0][r] = NEGBIG; } } } \
            _Pragma("unroll") for (int mp = 0; mp < NMAP; ++mp) { \
                _Pragma("unroll") for (int r = 0; r < 16; r += 4) { const float p0 = __builtin_amdgcn_exp2f(S[mp][r]), p1 = __builtin_amdgcn_exp2f(S[mp][r + 1]), p2 = __builtin_amdgcn_exp2f(S[mp][r + 2]), p3 = __builtin_amdgcn_exp2f(S[mp][r + 3]); \
                    ps0[mp] += p0; ps1[mp] += p1; ps2[mp] += p2; ps3[mp] += p3; S[mp][r] = p0; S[mp][r + 1] = p1; S[mp][r + 2] = p2; S[mp][r + 3] = p3; } \
                _Pragma("unroll") for (int s2 = 0; s2 < 2; ++s2) { u32x4 pw; pw.x = pg8::cvt_pk_bf16(S[mp][8 * s2 + 0], S[mp][8 * s2 + 1]); pw.y = pg8::cvt_pk_bf16(S[mp][8 * s2 + 2], S[mp][8 * s2 + 3]); \
                    pw.z = pg8::cvt_pk_bf16(S[mp][8 * s2 + 4], S[mp][8 * s2 + 5]); pw.w = pg8::cvt_pk_bf16(S[mp][8 * s2 + 6], S[mp][8 * s2 + 7]); pf[mp][2 * kb + s2] = __builtin_bit_cast(bf16x8, pw); } } } \
        _Pragma("unroll") for (int mp = 0; mp < NMAP; ++mp) lsum[mp] += (ps0[mp] + ps1[mp]) + (ps2[mp] + ps3[mp]); if (AF_SMPRIO) __builtin_amdgcn_s_setprio(0); } while (0)
#define AF_PV(sl) do { if (AF_PVPRIO) __builtin_amdgcn_s_setprio(1); _Pragma("unroll") for (int ks = 0; ks < 4; ++ks) { bf16x8 vf[2]; \
            _Pragma("unroll") for (int d0 = 0; d0 < 2; ++d0) { const s16x4 lo = vtr(lds + (sl) + vrd + d0 * 4096 + ks * 1024), hh = vtr(lds + (sl) + vrd + d0 * 4096 + ks * 1024 + 512); \
                vf[d0] = (bf16x8){lo[0], lo[1], lo[2], lo[3], hh[0], hh[1], hh[2], hh[3]}; } \
            _Pragma("unroll") for (int mp = 0; mp < NMAP; ++mp) { o[mp][0] = __builtin_amdgcn_mfma_f32_32x32x16_bf16(vf[0], pf[mp][ks], o[mp][0], 0, 0, 0); \
                o[mp][1] = __builtin_amdgcn_mfma_f32_32x32x16_bf16(vf[1], pf[mp][ks], o[mp][1], 0, 0, 0); AF_PROBE_MFMA(vf[0], vf[1], pf[mp][ks]); } } if (AF_PVPRIO) __builtin_amdgcn_s_setprio(0); } while (0)
#define AF_TOP(t) do { if (PRE && (t) < 2 && (t) + 1 < ntile) { static_assert(!PRE || PRE_ST == 8 || PRE_ST == 4 || PRE_ST == 0, "PRE_ST"); \
            if (PRE_ST == 8) asm volatile("s_waitcnt vmcnt(10)" ::: "memory"); else if (PRE_ST == 4) asm volatile("s_waitcnt vmcnt(6)" ::: "memory"); else asm volatile("s_waitcnt vmcnt(2)" ::: "memory"); } \
        else { const int ahead_ = min(LEAD - 1, ntile - 1 - (t));                 \
            if (ahead_ >= 3) asm volatile("s_waitcnt vmcnt(6)" ::: "memory"); else if (ahead_ == 2) asm volatile("s_waitcnt vmcnt(4)" ::: "memory"); \
            else if (ahead_ == 1) asm volatile("s_waitcnt vmcnt(2)" ::: "memory"); else asm volatile("s_waitcnt vmcnt(0)" ::: "memory"); } \
        __builtin_amdgcn_s_barrier(); asm volatile("" ::: "memory"); __builtin_amdgcn_sched_barrier(0); if ((t) + LEAD < ntile) AF_DMA((t) + LEAD); __builtin_amdgcn_sched_barrier(0); } while (0)
#define AF_NEXT(t) do { __builtin_amdgcn_sched_barrier(0); } while (0)
    if (AF_PRIO && lead) __builtin_amdgcn_s_setprio(1);
    if (lead) {
        for (int t = 0; t < ntile; ++t) { AF_TOP(t); const int sl = (t & (2 * LEAD - 1)) * 16384;
            AF_QKSM(sl, t); AF_PV(sl); AF_NEXT(t); }
    } else {
        { AF_TOP(0); AF_QKSM(0, 0); AF_NEXT(0); }
        for (int t = 1; t < ntile; ++t) { AF_TOP(t); const int sl = (t & (2 * LEAD - 1)) * 16384, slp = ((t - 1) & (2 * LEAD - 1)) * 16384;
            AF_PV(slp); __builtin_amdgcn_sched_barrier(0); AF_QKSM(sl, t); AF_NEXT(t); }
        { const int slp = ((ntile - 1) & (2 * LEAD - 1)) * 16384; AF_PV(slp); }
    }
#undef AF_TOP
#undef AF_NEXT
    if (AF_PRIO && lead) __builtin_amdgcn_s_setprio(0);
    if (PROBE_MFMA) asm volatile("" :: "v"(dmy));
    asm volatile("s_waitcnt lgkmcnt(0)" ::: "memory");
    __builtin_amdgcn_s_barrier();
    asm volatile("" ::: "memory");
#pragma unroll
    for (int mp = 0; mp < NMAP; ++mp) lsum[mp] = xor32_sum(lsum[mp]);
#undef AF_TILE
#undef AF_DMA
#undef AF_QKSM
#undef AF_PV
}

__device__ __forceinline__ void af_begin(LAS unsigned char* lds, const bf16_t* qw, const bf16_t* Kb, const bf16_t* Vb, int ta_lo, int ta_n, int tb_lo, int tb_n, bf16x8 (&qr)[4]) {
    int tid_l = threadIdx.x; asm volatile("" : "+v"(tid_l));
    const int tid = tid_l, lane = tid & 63, r32 = lane & 31, hi = lane >> 5, wid = __builtin_amdgcn_readfirstlane(tid >> 6);
    const int kkey = wid * 8 + (lane >> 3), kc = (lane & 7) ^ ((kkey >> 1) & 7);
    const size_t ksrc = (size_t)kkey * 64 + kc * 8;
    const size_t vsrc = (size_t)(16 * (wid & 3) + (lane >> 2)) * 64 + 32 * (wid >> 2) + (lane & 3) * 8;
#pragma unroll
    for (int s = 0; s < 4; ++s) qr[s] = *(const bf16x8*)(qw + (size_t)r32 * 64 + s * 16 + hi * 8);
    const unsigned lds0 = (unsigned)(uintptr_t)lds; const int ntile = ta_n + tb_n;
#pragma unroll
    for (int t = 0; t < 2; ++t) if (t < ntile) { const int T_ = t < ta_n ? ta_lo + t : tb_lo + t - ta_n; const unsigned so_ = lds0 + (unsigned)((t & 3) * 16384 + wid * 1024);
        glds16(Kb + (size_t)T_ * 4096 + ksrc, (unsigned)__builtin_amdgcn_readfirstlane(so_));
        glds16(Vb + (size_t)T_ * 4096 + vsrc, (unsigned)__builtin_amdgcn_readfirstlane(so_ + 8192u)); }
}

__device__ __forceinline__ void store_ot(bf16_t* yrow  , const f32x16 (&v)[2], int hi) {
#pragma unroll
    for (int d0 = 0; d0 < 2; ++d0)
#pragma unroll
        for (int g4 = 0; g4 < 4; ++g4) { u32x2 w; w.x = pg8::cvt_pk_bf16(v[d0][4 * g4], v[d0][4 * g4 + 1]); w.y = pg8::cvt_pk_bf16(v[d0][4 * g4 + 2], v[d0][4 * g4 + 3]);
            *(u32x2*)(yrow + d0 * 32 + 8 * g4 + 4 * hi) = w; }
}

__device__ __forceinline__ void store_ot_lds(bf16_t* yrow0  , const f32x16 (&v)[2], int lane, LAS unsigned char* stage) {
    const int r32 = lane & 31, hi = lane >> 5;
#pragma unroll
    for (int d0 = 0; d0 < 2; ++d0)
#pragma unroll
        for (int g4 = 0; g4 < 4; ++g4) { u32x2 w; w.x = pg8::cvt_pk_bf16(v[d0][4 * g4], v[d0][4 * g4 + 1]); w.y = pg8::cvt_pk_bf16(v[d0][4 * g4 + 2], v[d0][4 * g4 + 3]);
            *(LAS u32x2*)(stage + r32 * 144 + (d0 * 32 + 8 * g4 + 4 * hi) * 2) = w; }
    asm volatile("s_waitcnt lgkmcnt(0)" ::: "memory");
    u32x4 q[4];
#pragma unroll
    for (int j = 0; j < 4; ++j) q[j] = *(const LAS u32x4*)(stage + ((lane >> 3) + 8 * j) * 144 + (lane & 7) * 16);
#pragma unroll
    for (int j = 0; j < 4; ++j) *(u32x4*)(yrow0 + (size_t)((lane >> 3) + 8 * j) * D + (lane & 7) * 8) = q[j];
}

#ifndef REP_C
#define REP_C 1
#endif
#ifndef REP_AB
#define REP_AB 1
#endif
#ifndef MIX_DYNQ
#define MIX_DYNQ 1
#endif
__device__ __forceinline__ void mixers_phase(Frame& F, int l) {
    const bool ctxside = (l == 0);
#define MIX_LAUNDER() int tidm_ = threadIdx.x; asm volatile("" : "+v"(tidm_)); const int lane = tidm_ & 63, r32 = lane & 31, hi = lane >> 5, wv = __builtin_amdgcn_readfirstlane(tidm_ >> 6); \
    unsigned char* r1; { GAS unsigned char* r1g_ = (GAS unsigned char*)(F.ws + WS_R1); asm volatile("" : "+s"(r1g_)); r1 = (unsigned char*)r1g_; } bf16_t* Y = (bf16_t*)(r1 + R1_H);
    for (int repc_ = 0; repc_ < REP_C; ++repc_) { if (repc_) __syncthreads();
        MIX_LAUNDER();
        const bf16_t *QC = (const bf16_t*)(r1 + R1_QC), *KC = (const bf16_t*)(r1 + R1_KC), *VC = (const bf16_t*)(r1 + R1_VC);
        const float lam_init = (l == 0) ? 0.2f : 0.3555090675909693f;
        float lam;
        { float a = (lane < 32) ? INP(I_LQ1)[l * 32 + lane] * INP(I_LK1)[l * 32 + lane] : 0.f, b = (lane < 32) ? INP(I_LQ2)[l * 32 + lane] * INP(I_LK2)[l * 32 + lane] : 0.f;
            lam = __expf(wave_sum(a)) - __expf(wave_sum(b)) + lam_init; }
        const int nC = 512 + (ctxside ? 8 : 0);
        for (int u = F.bid; u < nC; u += F.G) {
            int bh, pos0, ta_n; size_t yrow0;
            if (u < 512) { bh = u & 7; const int qb = u >> 3; pos0 = CTX + qb * 256 + wv * 32; ta_n = KEYS / 64; yrow0 = (size_t)(bh >> 2) * SEQ + qb * 256 + wv * 32; }
            else { bh = u - 512; pos0 = wv * 32; ta_n = CTX / 64; yrow0 = (size_t)NLAT + (bh >> 2) * CTX + wv * 32; }
            f32x16 o[2][2]; float ls[2];
            bool fast;
            { const unsigned* bw = (const unsigned*)(F.ws + WS_CTL) + CW_BND + l * 128;
              const float q0 = __uint_as_float(__hip_atomic_load(bw + bh * 2, RLX_AGENT)), q1 = __uint_as_float(__hip_atomic_load(bw + bh * 2 + 1, RLX_AGENT));
              const float k0 = __uint_as_float(__hip_atomic_load(bw + 16 + bh * 2, RLX_AGENT)), k1 = __uint_as_float(__hip_atomic_load(bw + 16 + bh * 2 + 1, RLX_AGENT));
              fast = (q0 * k0 < 3600.f) && (q1 * k1 < 3600.f); fast = __builtin_amdgcn_readfirstlane(fast ? 1 : 0) != 0; }
            bf16x8 qrc[4];
            if (fast) attn_fast<2>(F.lds, QC + ((size_t)bh * KEYS + pos0) * 64, KC + (size_t)bh * KEYS * 64, VC + (size_t)bh * KEYS * 64, 0, ta_n, 0, 0, -1, 0.f, o, ls, qrc);
            else attn_unit<2>(F.lds, QC + ((size_t)bh * KEYS + pos0) * 64, KC + (size_t)bh * KEYS * 64, VC + (size_t)bh * KEYS * 64, 0, ta_n, 0, 0, -1, NEGBIG, 0.f, o, ls);
            const float i1 = 1.f / ls[0], i2 = lam / ls[1];
            f32x16 v[2]; float ss = 0.f;
#pragma unroll
            for (int d0 = 0; d0 < 2; ++d0)
#pragma unroll
                for (int r = 0; r < 16; ++r) { const float x = o[0][d0][r] * i1 - o[1][d0][r] * i2; v[d0][r] = x; ss += x * x; }
            ss = xor32_sum(ss);
            const float rn = (1.f - lam_init) / sqrtf(ss * (1.f / 64.f) + EPS);
            const float* gs = INP(I_GSUB) + l * 64;
#pragma unroll
            for (int d0 = 0; d0 < 2; ++d0)
#pragma unroll
                for (int r = 0; r < 16; ++r) v[d0][r] *= rn * gs[d0 * 32 + crow(r, hi)];
            store_ot(Y + (yrow0 + r32) * D + 768 + (bh & 3) * 64, v, hi);
        }
    }
    for (int repa_ = 0; repa_ < REP_AB; ++repa_) { if (repa_) __syncthreads();
        MIX_LAUNDER();
        const bf16_t *QA = (const bf16_t*)(r1 + R1_QA), *KA = (const bf16_t*)(r1 + R1_KA), *VA = (const bf16_t*)(r1 + R1_VA);
        unsigned okmask = 0u;
        { const unsigned* bw = (const unsigned*)(F.ws + WS_CTL) + CW_BND + l * 128;
          for (int bhd = 0; bhd < 16; ++bhd) { const int b2 = bhd >> 3, hd = bhd & 7, kv = hd >> 2;
              const float kk = __uint_as_float(__hip_atomic_load(bw + 64 + b2 * 4 + kv * 2, RLX_AGENT)) + __uint_as_float(__hip_atomic_load(bw + 64 + b2 * 4 + kv * 2 + 1, RLX_AGENT));
              const float qq = __uint_as_float(__hip_atomic_load(bw + 32 + b2 * 16 + hd * 2, RLX_AGENT)) + __uint_as_float(__hip_atomic_load(bw + 32 + b2 * 16 + hd * 2 + 1, RLX_AGENT));
              const bool ok = (qq * kk < 3600.f) && (fabsf(INP(I_SINK)[l * 8 + hd]) * LOG2E < 60.f);
              okmask |= (ok ? 1u : 0u) << bhd; }
          okmask = (unsigned)__builtin_amdgcn_readfirstlane((int)okmask); }
        const int nA = 1024 + (ctxside ? 16 : 0);
        const int nCv = (l == 0 && MIX_DYNQ) ? CV_UNITS : 0, nQ = nA + nCv;
        unsigned* qctrA = (unsigned*)(F.ws + WS_CTL) + CW_MIXQ + l * 2 + repa_ * 4;
        volatile LAS int* qw_ = (volatile LAS int*)(F.lds + TBL_OFF);
        int qnxt = 0; if (tidm_ == 0) qnxt = (int)__hip_atomic_fetch_add(qctrA, 1u, __ATOMIC_RELAXED, __HIP_MEMORY_SCOPE_AGENT);
        auto pop = [&]() -> int { if (tidm_ == 0) { qw_[0] = qnxt; } __syncthreads(); int u = qw_[0]; __syncthreads();
            if (u < nQ && tidm_ == 0) qnxt = (int)__hip_atomic_fetch_add(qctrA, 1u, __ATOMIC_RELAXED, __HIP_MEMORY_SCOPE_AGENT);
            return __builtin_amdgcn_readfirstlane(u); };
        struct AU { int b, head, pos0, qlat, tb_lo, tb_n; size_t yrow0; bool fast; };
        auto decode = [&](int u, AU& a) -> int {
            if (u >= nQ) return 0;
            if (nCv) { const int cvb = (u * nCv) / nQ, cva = ((u + 1) * nCv) / nQ; if (cva != cvb) { a.b = cvb; return 2; } u -= cvb; }
            unsigned need;
            if (u < 1024) { const int kvg = u & 1, i = (u >> 1) & 255; a.b = u >> 9; a.head = 4 * kvg + (wv >> 1); const int q0 = i * 64 + (wv & 1) * 32;
                a.pos0 = CTX + q0; a.qlat = q0 + r32; const int tlo = max(i - 2, 0), thi = min(i + 2, SEQ / 64 - 1); a.tb_lo = 4 + tlo; a.tb_n = thi - tlo + 1; a.yrow0 = (size_t)a.b * SEQ + q0; need = 0xFu << (a.b * 8 + 4 * kvg); }
            else { const int q = u - 1024; a.b = q >> 3; a.head = q & 7; a.pos0 = wv * 32; a.qlat = -1; a.tb_lo = 0; a.tb_n = 0; a.yrow0 = (size_t)NLAT + a.b * CTX + wv * 32; need = 1u << (a.b * 8 + a.head); }
            a.fast = (okmask & need) == need;
            return 1; };
#define AQ(a) (QA + ((size_t)((a).b * 8 + (a).head) * KEYS + (a).pos0) * 64)
#define AK(a) (KA + (size_t)((a).b * 2 + ((a).head >> 2)) * KEYS * 64)
#define AV(a) (VA + (size_t)((a).b * 2 + ((a).head >> 2)) * KEYS * 64)
        AU cur; int kind = decode(pop(), cur); bool pre = false; bf16x8 qr[4];
        while (kind) {
            if (kind == 2) { p0_items(F, P0_EARLY + cur.b * CV_PER_UNIT + wv, NWAVES, CV_PER_UNIT / NWAVES, (LAS float*)(F.lds + wv * 16384), lane); kind = decode(pop(), cur); pre = false; continue; }
            f32x16 o[1][2]; float ls[1];
            const float sink2 = INP(I_SINK)[l * 8 + cur.head] * LOG2E;
            if (cur.fast) { const float li = hi == 0 ? __builtin_amdgcn_exp2f(sink2) : 0.f;
                if (pre) attn_fast<1, true, 8>(F.lds, AQ(cur), AK(cur), AV(cur), 0, CTX / 64, cur.tb_lo, cur.tb_n, cur.qlat, li, o, ls, qr);
                else { attn_fast<1, false, 0, A_LEAD>(F.lds, AQ(cur), AK(cur), AV(cur), 0, CTX / 64, cur.tb_lo, cur.tb_n, cur.qlat, li, o, ls, qr);
#if PROBE_A2
                    asm volatile("" :: "v"(o[0][0]), "v"(o[0][1]), "v"(ls[0]) : "memory"); attn_fast<1, false, 0, A_LEAD>(F.lds, AQ(cur), AK(cur), AV(cur), 0, CTX / 64, cur.tb_lo, cur.tb_n, cur.qlat, li, o, ls, qr);
#endif
                } }
            else attn_unit<1>(F.lds, AQ(cur), AK(cur), AV(cur), 0, CTX / 64, cur.tb_lo, cur.tb_n, cur.qlat, sink2, hi == 0 ? 1.f : 0.f, o, ls);
            AU nx; const int kn = decode(pop(), nx); const bool pren = (A_LEAD == 2) && (kn == 1) && nx.fast;
            if (pren) af_begin(F.lds, AQ(nx), AK(nx), AV(nx), 0, CTX / 64, nx.tb_lo, nx.tb_n, qr);
            const float inv = 1.f / ls[0];
            f32x16 v[2]; v[0] = o[0][0] * inv; v[1] = o[0][1] * inv;
            store_ot(Y + (cur.yrow0 + r32) * D + cur.head * 64, v, hi);
            cur = nx; kind = kn; pre = pren;
        }
#undef AQ
#undef AK
#undef AV
    }
    for (int repb_ = 0; repb_ < REP_AB; ++repb_) { if (repb_) __syncthreads();
        MIX_LAUNDER();
        const bf16_t *BU = (const bf16_t*)(r1 + R1_BU), *BV = (const bf16_t*)(r1 + R1_BV);
        const int nB = (ctxside ? NROW / 128 : NLAT / 128) * 4;
        LAS bf16_t* vnT = (LAS bf16_t*)F.lds;
        const bf16_t* WS = (const bf16_t*)(F.ws + WS_WSTOK) + (size_t)l * 4 * 128 * 128;
        unsigned* qctrB = (unsigned*)(F.ws + WS_CTL) + CW_MIXQ + l * 2 + 1 + repb_ * 4;
        volatile LAS int* qw_ = (volatile LAS int*)(F.lds + TBL_OFF);
        int qnxt = 0; if (MIX_DYNQ && tidm_ == 0) qnxt = (int)__hip_atomic_fetch_add(qctrB, 1u, __ATOMIC_RELAXED, __HIP_MEMORY_SCOPE_AGENT);
        for (int u = (F.bid + F.G - 24) % F.G; ; u += F.G) {
            if (MIX_DYNQ) { if (tidm_ == 0) { qw_[0] = qnxt; } __syncthreads(); u = qw_[0]; __syncthreads();
                if (u < nB && tidm_ == 0) qnxt = (int)__hip_atomic_fetch_add(qctrB, 1u, __ATOMIC_RELAXED, __HIP_MEMORY_SCOPE_AGENT); }
            u = __builtin_amdgcn_readfirstlane(u);
            if (u >= nB) break;
            const int g = u & 3, rc = u >> 2, row0 = rc * 128;
            { const int ftid = tidm_;
                const int p = ftid >> 2, dq = ftid & 3;
                const u32x4* src = (const u32x4*)(BV + (size_t)(row0 + p) * 256 + g * 64 + dq * 16);
                const u32x4 a = src[0], b4 = src[1]; float x[16];
                x[0] = bflo(a.x); x[1] = bfhi(a.x); x[2] = bflo(a.y); x[3] = bfhi(a.y); x[4] = bflo(a.z); x[5] = bfhi(a.z); x[6] = bflo(a.w); x[7] = bfhi(a.w);
                x[8] = bflo(b4.x); x[9] = bfhi(b4.x); x[10] = bflo(b4.y); x[11] = bfhi(b4.y); x[12] = bflo(b4.z); x[13] = bfhi(b4.z); x[14] = bflo(b4.w); x[15] = bfhi(b4.w);
                float s = 0.f;
#pragma unroll
                for (int i = 0; i < 16; ++i) { x[i] = gelu_tanh(x[i]); s += x[i]; }
                s += __shfl_xor(s, 1); s += __shfl_xor(s, 2);
                const float mu = s * (1.f / 64.f); float q = 0.f;
#pragma unroll
                for (int i = 0; i < 16; ++i) { x[i] -= mu; q += x[i] * x[i]; }
                q += __shfl_xor(q, 1); q += __shfl_xor(q, 2);
                const float rs = 1.f / sqrtf(q * (1.f / 64.f) + EPS);
                const float* gt = INP(I_GTOK) + (l * 4 + g) * 64 + dq * 16;
#pragma unroll
                for (int i = 0; i < 16; ++i) vnT[(dq * 16 + i) * 136 + p] = (bf16_t)(pg8::cvt_pk_bf16(x[i] * rs * gt[i], 0.f) & 0xffffu);
            }
            __syncthreads();
            const int pblk = wv >> 1, dblk = wv & 1;
            f32x16 acc = f32x16{};
            const bf16_t* wsr = WS + ((size_t)g * 128 + pblk * 32 + r32) * 128 + hi * 8;
#pragma unroll
            for (int s = 0; s < 8; ++s) { const bf16x8 wf = *(const bf16x8*)(wsr + s * 16);
                const bf16x8 vfr = *(const LAS bf16x8*)(vnT + (dblk * 32 + r32) * 136 + s * 16 + hi * 8);
                acc = __builtin_amdgcn_mfma_f32_32x32x16_bf16(vfr, wf, acc, 0, 0, 0); }
            const int p = pblk * 32 + r32;
            const float bsp = INP(I_BSTOK)[(l * 4 + g) * 128 + p];
            const bf16_t* up = BU + (size_t)(row0 + p) * 256 + g * 64 + dblk * 32 + 4 * hi;
            bf16_t* yp = Y + (size_t)(row0 + p) * D + 512 + g * 64 + dblk * 32 + 4 * hi;
#pragma unroll
            for (int g4 = 0; g4 < 4; ++g4) { const u32x2 uw = *(const u32x2*)(up + 8 * g4);
                const float y0 = gelu_tanh(bflo(uw.x)) * (acc[4 * g4] + bsp), y1 = gelu_tanh(bfhi(uw.x)) * (acc[4 * g4 + 1] + bsp), y2 = gelu_tanh(bflo(uw.y)) * (acc[4 * g4 + 2] + bsp), y3 = gelu_tanh(bfhi(uw.y)) * (acc[4 * g4 + 3] + bsp);
                *(u32x2*)(yp + 8 * g4) = (u32x2){pg8::cvt_pk_bf16(y0, y1), pg8::cvt_pk_bf16(y2, y3)}; }
            __syncthreads();
        }
    }
}

#ifndef REP_N0
#define REP_N0 1
#endif
#ifndef REP_P0
#define REP_P0 1
#endif
#ifndef REP_RT
#define REP_RT 1
#endif
#ifndef REP_PM
#define REP_PM 1
#endif
#ifndef REP_GEMM
#define REP_GEMM 1
#endif
#ifndef REP_MIX
#define REP_MIX 1
#endif
#ifndef MOE_MERGE
#define MOE_MERGE 1
#endif
struct Args { const float* in[27]; float* out; unsigned char* ws; int ph_lo, ph_hi; };
__global__ void __launch_bounds__(NTHR, 2) fwd_kernel(Args args) {
    extern __shared__ __attribute__((aligned(16))) unsigned char lds_raw[];
    Frame F;
    F.lds = (LAS unsigned char*)lds_raw;
    F.tid = threadIdx.x; F.lane = F.tid & 63; F.wave = __builtin_amdgcn_readfirstlane(F.tid >> 6);
    F.G = gridDim.x; F.bid = blockIdx.x;
    F.out = args.out; F.ws = args.ws;
    volatile LAS unsigned* MISC = (volatile LAS unsigned*)(F.lds + MISC_OFF);
    for (int u = F.tid; u < 64; u += NTHR) MISC[u] = 0u;
    __syncthreads();
    const int lo = args.ph_lo, hi = args.ph_hi;
    unsigned* barw = (unsigned*)(F.ws + WS_CTL) + CW_BAR;
    XcdBarrier bar; bar.bar = barw; bar.x = 0; bar.st = nullptr;
    const bool multi = (hi - lo) > 1;
    if (multi) bar = xcd_barrier_post(barw, MISC + 8);
#ifdef ONLY_PH
#define IN(k) (((k) == 0 ? 0 : (((k) - 1) % 8) + 1) == ONLY_PH && lo <= (k) && (k) < hi)
#else
#define IN(k) (lo <= (k) && (k) < hi)
#endif
#define SEAM(k) do { if (IN(k) && IN((k) + 1)) xcd_barrier(bar); LAUNDER(); } while (0)
#define LAUNDER() do { asm volatile("" : "+v"(F.tid), "+v"(F.lane)); asm volatile("" : "+s"(F.wave), "+s"(F.G), "+s"(F.bid)); { GAS unsigned char* ws_ = (GAS unsigned char*)F.ws; GAS float* out_ = (GAS float*)F.out; asm volatile("" : "+s"(ws_), "+s"(out_)); F.ws = (unsigned char*)ws_; F.out = (float*)out_; } } while (0)
    LAS int* tb = (LAS int*)(F.lds + TBL_OFF);

    LAUNDER();
    if (IN(0)) for (int rep_ = 0; rep_ < REP_P0; ++rep_) { if (rep_) { __syncthreads(); LAUNDER(); } p0_prologue(F); } SEAM(0);
    for (int l = 0; l < 2; ++l) {
        const int pb = 1 + 8 * l;
        const int Mlay = (l == 0) ? NROW : NLAT;
        if (IN(pb + 0)) { if (l == 0) { for (int rep_ = 0; rep_ < REP_N0; ++rep_) { if (rep_) LAUNDER(); norm_phase<0>(F, l); } } else norm_phase<1>(F, l);
        } SEAM(pb + 0);
        if (IN(pb + 1)) for (int rep_ = 0; rep_ < REP_GEMM; ++rep_) {
            if (rep_) { __syncthreads(); LAUNDER(); }
            pg8::Gemm g{(const bf16_t*)(F.ws + WS_R1 + R1_H), (const bf16_t*)(F.ws + WS_WIN) + (size_t)l * DIN * D, NROW, DIN, D, 0, nullptr};
            pg8::StaticOrder S; S.init(NLAT, DIN, F.G, F.bid);
            EpiProj E{F.ws + WS_R1, (const f32x2*)(F.ws + WS_TABA), (const f32x2*)(F.ws + WS_TABC), (unsigned*)(F.ws + WS_CTL) + CW_BND + l * 128};
            pg8::gemm_phase<EpiProj, pg8::StaticOrder, true, true>(F.lds, g, S, E);
            { LAUNDER(); CtxEpiProj CE{F.ws + WS_R1, (unsigned*)(F.ws + WS_CTL) + CW_BND + l * 128};
              ctx_gemm<CtxEpiProj>(F, (const bf16_t*)(F.ws + WS_R1 + R1_H) + (size_t)NLAT * D, (const bf16_t*)(F.ws + WS_WIN) + (size_t)l * DIN * D, DIN, CE); }
        } SEAM(pb + 1);
        if (IN(pb + 2)) for (int rep_ = 0; rep_ < REP_MIX; ++rep_) { if (rep_) { __syncthreads(); LAUNDER(); } mixers_phase(F, l); } SEAM(pb + 2);
        if (IN(pb + 3)) {
            pg8::Gemm g{(const bf16_t*)(F.ws + WS_R1 + R1_H), (const bf16_t*)(F.ws + WS_WOUT) + (size_t)l * D * D, NLAT, D, D, 0, nullptr};
            pg8::StaticOrder S; S.init(NLAT, D, F.G, F.bid);
            EpiOut E{l == 0 ? INP(I_X) : (const float*)nullptr, (bf16_t*)(F.ws + WS_XS), (const float*)(F.ws + WS_MOD) + (size_t)l * 3 * 6144};
            pg8::gemm_phase<EpiOut, pg8::StaticOrder, true, true>(F.lds, g, S, E);
            if (l == 0) { LAUNDER(); CtxEpiOut CE{INP(I_CTX), (bf16_t*)(F.ws + WS_XS) + (size_t)NLAT * D, (const float*)(F.ws + WS_MOD) + (size_t)(l * 3 + 2) * 6144 + 2 * D};
              ctx_gemm<CtxEpiOut>(F, (const bf16_t*)(F.ws + WS_R1 + R1_H) + (size_t)NLAT * D, (const bf16_t*)(F.ws + WS_WOUT) + (size_t)l * D * D, D, CE); }
        } SEAM(pb + 3);
        if (IN(pb + 4)) for (int rep_ = 0; rep_ < REP_RT; ++rep_) { if (rep_) { __syncthreads(); LAUNDER(); } route_phase(F, l, Mlay); } SEAM(pb + 4);
        if (IN(pb + 5)) for (int rep_ = 0; rep_ < REP_PM; ++rep_) { if (rep_) { __syncthreads(); LAUNDER(); } permute_phase(F, l, Mlay); } SEAM(pb + 5);
        if (IN(pb + 6)) for (int rep_ = 0; rep_ < REP_GEMM; ++rep_) {
            LAUNDER(); __syncthreads(); load_tile_bases(F, l, tb);
            LAS int* gmap = (LAS int*)(F.lds + GMAP_OFF);
            GroupedOrder S{4, F.G, F.bid, tb[NEXP] * 4, tb, MOE_MERGE ? (unsigned*)(F.ws + WS_CTL) + CW_MOEC + l * 8192 : (unsigned*)nullptr};
            { pg8::Unit uu; const int* ROWMAP = (const int*)(F.ws + WS_ROWMAP);
              for (int i = 0; i < GMAP_UNITS && S.next(i, uu); ++i) if (F.tid < 256) gmap[i * 256 + F.tid] = ROWMAP[uu.pm * 256 + F.tid];
              __syncthreads(); }
            pg8::Gemm g{(const bf16_t*)(F.ws + WS_R1 + R1_H2), (const bf16_t*)(F.ws + WS_WGU) + (size_t)l * NEXP * 1024 * D, MOE_ROWS, 1024, D, (size_t)1024 * D * 2, gmap};
            EpiMoe1 E{(bf16_t*)(F.ws + WS_R1 + R1_HE)};
            pg8::gemm_phase<EpiMoe1, GroupedOrder, true, true, true>(F.lds, g, S, E);
        } if (!MOE_MERGE) SEAM(pb + 6); else LAUNDER();
        if (IN(pb + 7)) for (int rep_ = 0; rep_ < REP_GEMM; ++rep_) {
            LAUNDER(); __syncthreads(); load_tile_bases(F, l, tb);
            pg8::Gemm g{(const bf16_t*)(F.ws + WS_R1 + R1_HE), (const bf16_t*)(F.ws + WS_WD) + (size_t)l * NEXP * D * DEXP, MOE_ROWS, D, DEXP, (size_t)D * DEXP * 2, nullptr};
#if MOE_MERGE
            GroupedOrder2 S{F.G, F.bid, tb[NEXP] * 4, tb, (unsigned*)(F.ws + WS_CTL) + CW_MOEC + l * 8192};
#else
            GroupedOrder S{4, F.G, F.bid, tb[NEXP] * 4, tb, nullptr};
#endif
            EpiMoe2 E{(bf16_t*)(F.ws + WS_R2), (const int*)(F.ws + WS_ROWMAP), (const float*)(F.ws + WS_WSLOT)};
#if MOE_MERGE
            pg8::gemm_phase<EpiMoe2, GroupedOrder2, true, true>(F.lds, g, S, E);
#else
            pg8::gemm_phase<EpiMoe2, GroupedOrder, true, true>(F.lds, g, S, E);
#endif
        } SEAM(pb + 7);
    }
    if (IN(17)) { norm_phase<2>(F, 1); }
#undef IN
#undef SEAM
}

#ifndef MK_PER_PHASE
#define MK_PER_PHASE 0
#endif
extern "C" void kernel_launch(void* const* d_in, const int* in_sizes, int n_in, void* d_out, int out_size, void* d_ws, size_t ws_size, hipStream_t stream) {
    static int grid = 0;
    if (grid == 0) {
        if (n_in != 27 || out_size != NLAT * D || ws_size < WS_END) { fprintf(stderr, "kernel_launch: unexpected problem (n_in %d out %d ws %zu)\n", n_in, out_size, ws_size); grid = -1; return; }
        if (hipFuncSetAttribute((const void*)fwd_kernel, hipFuncAttributeMaxDynamicSharedMemorySize, LDS_BYTES) != hipSuccess) { fprintf(stderr, "kernel_launch: hipFuncSetAttribute failed\n"); grid = -1; return; }
        int dev = 0, cus = 0, per_cu = 0;
        if (hipGetDevice(&dev) != hipSuccess || hipDeviceGetAttribute(&cus, hipDeviceAttributeMultiprocessorCount, dev) != hipSuccess) { grid = -1; return; }
        if (hipOccupancyMaxActiveBlocksPerMultiprocessor(&per_cu, (const void*)fwd_kernel, NTHR, LDS_BYTES) != hipSuccess || per_cu < 1) fprintf(stderr, "kernel_launch: occupancy query says %d\n", per_cu);
        (void)hipGetLastError();
        grid = cus < 256 ? cus : 256;
    }
    if (grid < 0) return;
    if (hipMemsetAsync((char*)d_ws + WS_CTL, 0, CTL_ZERO_BYTES, stream) != hipSuccess) return;
    Args a{};
    for (int i = 0; i < 27; ++i) a.in[i] = (const float*)d_in[i];
    a.out = (float*)d_out; a.ws = (unsigned char*)d_ws;
#if MK_PER_PHASE
    for (int p = 0; p < N_PHASES; ++p) { a.ph_lo = p; a.ph_hi = p + 1; hipLaunchKernelGGL(fwd_kernel, dim3(grid), dim3(NTHR), LDS_BYTES, stream, a); }
#else
    a.ph_lo = 0; a.ph_hi = N_PHASES;
    hipLaunchKernelGGL(fwd_kernel, dim3(grid), dim3(NTHR), LDS_BYTES, stream, a);
#endif
}
```

```cpp
#include <hip/hip_runtime.h>
#include <cstdio>
#include <cstdint>
#ifndef PROBE_EPI2
#define PROBE_EPI2 0
#endif

#define LAS __attribute__((address_space(3)))
#define GAS __attribute__((address_space(1)))
typedef unsigned short bf16_t;
typedef unsigned short f16s_t;
typedef _Float16 f16x2_t __attribute__((ext_vector_type(2)));
typedef short bf16x8 __attribute__((ext_vector_type(8)));
typedef short s16x4 __attribute__((ext_vector_type(4)));
typedef float f32x4 __attribute__((ext_vector_type(4)));
typedef float f32x2 __attribute__((ext_vector_type(2)));
typedef float f32x16 __attribute__((ext_vector_type(16)));
typedef unsigned u32x4 __attribute__((ext_vector_type(4)));
typedef unsigned u32x2 __attribute__((ext_vector_type(2)));

typedef float f32x2_h __attribute__((ext_vector_type(2)));
__device__ __forceinline__ unsigned cvt_pk_f16(float lo, float hi) { f32x2_h v = {lo, hi}; f16x2_t h = __builtin_convertvector(v, f16x2_t); return __builtin_bit_cast(unsigned, h); }
__device__ __forceinline__ float hflo(unsigned w) { return (float)__builtin_bit_cast(f16x2_t, w)[0]; }
__device__ __forceinline__ float hfhi(unsigned w) { return (float)__builtin_bit_cast(f16x2_t, w)[1]; }

namespace pg8 {
#define PG8_LAS __attribute__((address_space(3)))
constexpr int BM = 256, BK = 64, HALF = 128, HTB = HALF * BK * 2, STAGE_BYTES = 8 * HTB, NXCD = 8, WGM = 8;
__host__ __device__ __forceinline__ int lds_byte(int r, int c) { const int st = (r >> 4) * 2 + (c >> 5), rr = r & 15, cc = c & 31, ob = rr * 64 + cc * 2; return st * 1024 + (ob ^ (((ob >> 9) & 1) << 5)); }
__host__ __device__ __forceinline__ void stage_rc(int b, int& R, int& C) { const int st = b / 1024, sb = b % 1024, swz = sb ^ (((sb >> 9) & 1) << 5); R = (st >> 1) * 16 + swz / 64; C = (st & 1) * 32 + (swz % 64) / 2; }
__host__ __device__ __forceinline__ int perm32(int rho) { const int n = rho >> 4, i = rho & 15; return 8 * (i >> 2) + 4 * n + (i & 3); }

struct Unit { int pm, pn, be; };
struct Gemm { const bf16_t* A; const bf16_t* Bt; int M, N, K; size_t bstride; const PG8_LAS int* gmap; };

struct StaticOrder {
    int nM, nN, nwg, G, c;
    __host__ __device__ void init(int M, int N, int G_, int c_) { nM = M / BM; nN = N / BM; nwg = nM * nN; G = G_; c = c_; }
    __host__ __device__ bool next(int i, Unit& u) const {
        const long L = (long)i * G + c; if (L >= nwg) return false;
        int wgid = (int)L; { const int q = nwg / NXCD, r = nwg % NXCD, xcd = wgid % NXCD, off = wgid / NXCD; wgid = (xcd < r ? xcd * (q + 1) : r * (q + 1) + (xcd - r) * q) + off; }
        const int nig = WGM * nN, gid = wgid / nig, fm = gid * WGM, gsz = (nM - fm) < WGM ? (nM - fm) : WGM;
        u.pm = fm + ((wgid % nig) % gsz); u.pn = (wgid % nig) / gsz; u.be = 0; return true;
    }
    __device__ __forceinline__ void a_ready(const Unit&) const {}
    __device__ __forceinline__ void done(const Unit&) const {}
};
typedef __bf16 bf16x2_t __attribute__((ext_vector_type(2)));
__device__ __forceinline__ unsigned cvt_pk_bf16(float lo, float hi) { f32x2 v = {lo, hi}; bf16x2_t b = __builtin_convertvector(v, bf16x2_t); return __builtin_bit_cast(unsigned, b); }

template <class Epi, class Sched, bool ALIGN_EPI = false, bool SP2 = false, bool GATHER = false>
__device__ __forceinline__ void gemm_phase(PG8_LAS unsigned char* lds, const Gemm g, const Sched& S, const Epi& E) {
    int tid_l = threadIdx.x; asm volatile("" : "+v"(tid_l));
    const int tid = tid_l, wid = __builtin_amdgcn_readfirstlane(tid >> 6), lane = tid & 63, wr = wid >> 2, wc = wid & 3, fr = lane & 15, fq = lane >> 4;
    const int K = g.K, nt = K / BK;
    unsigned voffA[2], voffB[2];
#pragma unroll
    for (int i = 0; i < 2; ++i) { int R, C; stage_rc(tid * 16 + i * 8192, R, C); const int Rb = Epi::PERM ? ((R & ~31) + perm32(R & 31)) : R;
        voffA[i] = (unsigned)(R * K + C) * 2u; voffB[i] = (unsigned)(Rb * K + C) * 2u; }
    const size_t kstep = (size_t)(BK * 2);
    const size_t hstep = (size_t)HALF * K * 2;
    const size_t tstep = GATHER ? 0 : 2 * hstep;
    const unsigned ldsw = (unsigned)wid * 1024u;
    const int aoff = lds_byte(wr * 64 + fr, fq * 8), boff = lds_byte(wc * 32 + fr, fq * 8);
#define PG8_SA(b, h) (((b) * 2 + (h)) * HTB)
#define PG8_SB(b, h) ((4 + (b) * 2 + (h)) * HTB)
#define PG8_STAGE(bufoff, gbase, voff) do { _Pragma("unroll") for (int _i = 0; _i < 2; ++_i) \
        __builtin_amdgcn_global_load_lds((const unsigned*)((const char*)(gbase) + (voff)[_i]), (PG8_LAS unsigned*)(lds + (bufoff) + ldsw + _i * 8192), 16, 0, 0); } while (0)
#define PG8_LDA(dst, b, h) do { _Pragma("unroll") for (int m = 0; m < 4; ++m) _Pragma("unroll") for (int k = 0; k < 2; ++k) dst[m][k] = *(const PG8_LAS bf16x8*)(lds + PG8_SA(b, h) + aoff + m * 2048 + k * 1024); } while (0)
#define PG8_LDB(dst, b, h) do { _Pragma("unroll") for (int n = 0; n < 2; ++n) _Pragma("unroll") for (int k = 0; k < 2; ++k) dst[n][k] = *(const PG8_LAS bf16x8*)(lds + PG8_SB(b, h) + boff + n * 2048 + k * 1024); } while (0)
#define PG8_MMA(ai, bj, At, Bt) do { __builtin_amdgcn_s_setprio(1); _Pragma("unroll") for (int m = 0; m < 4; ++m) _Pragma("unroll") for (int n = 0; n < 2; ++n) _Pragma("unroll") for (int k = 0; k < 2; ++k) \
        acc[ai][bj][m][n] = __builtin_amdgcn_mfma_f32_16x16x32_bf16(Bt[n][k], At[m][k], acc[ai][bj][m][n], 0, 0, 0); __builtin_amdgcn_s_setprio(0); } while (0)
#define PG8_WAIT_V(n) asm volatile("s_waitcnt vmcnt(" #n ")" ::: "memory")
#define PG8_WAIT_L(n) asm volatile("s_waitcnt lgkmcnt(" #n ")" ::: "memory")
#define PG8_BAR __builtin_amdgcn_s_barrier()
#define PG8_SCHED __builtin_amdgcn_sched_barrier(0)
    Unit cur, nxt; int ui = 0;
    if (!S.next(0, cur)) return;
    f32x4 acc[2][2][4][2];
#pragma unroll
    for (int a = 0; a < 2; ++a)
#pragma unroll
        for (int b = 0; b < 2; ++b)
#pragma unroll
            for (int m = 0; m < 4; ++m)
#pragma unroll
                for (int n = 0; n < 2; ++n) acc[a][b][m][n] = (f32x4){0.f, 0.f, 0.f, 0.f};
    bf16x8 At[4][2], B0[2][2], B1[2][2];
    unsigned vA0[2] = {0u, 0u}, vA1[2] = {0u, 0u}, nvA0[2] = {0u, 0u}, nvA1[2] = {0u, 0u};
#define PG8_GOFF(dst0, dst1, unit) do { _Pragma("unroll") for (int i_ = 0; i_ < 2; ++i_) { int R_, C_; stage_rc(tid * 16 + i_ * 8192, R_, C_); \
        const int m0_ = g.gmap[(unit) * 256 + R_], m1_ = g.gmap[(unit) * 256 + 128 + R_]; \
        dst0[i_] = (unsigned)((m0_ < 0 ? 0 : (m0_ >> 1)) * K + C_) * 2u; dst1[i_] = (unsigned)((m1_ < 0 ? 0 : (m1_ >> 1)) * K + C_) * 2u; } } while (0)
#define PG8_STAGE_A(bufoff, p, h, nx) do { if constexpr (GATHER) { unsigned tv_[2]; \
        tv_[0] = (nx) ? ((h) ? nvA1[0] : nvA0[0]) : ((h) ? vA1[0] : vA0[0]); tv_[1] = (nx) ? ((h) ? nvA1[1] : nvA0[1]) : ((h) ? vA1[1] : vA0[1]); PG8_STAGE(bufoff, p, tv_); } \
        else PG8_STAGE(bufoff, (p) + (h) * hstep, voffA); } while (0)
    const char* cA = (const char*)g.A + (size_t)cur.pm * tstep; const size_t btstep = 2 * (size_t)HALF * K * 2; const char* cB = (const char*)g.Bt + (size_t)cur.be * g.bstride + (size_t)cur.pn * btstep;
    S.a_ready(cur);
    if constexpr (GATHER) PG8_GOFF(vA0, vA1, 0);
    if constexpr (SP2) {
        PG8_STAGE(PG8_SB(0, 0), cB, voffB); PG8_STAGE(PG8_SB(0, 1), cB + hstep, voffB); PG8_STAGE_A(PG8_SA(0, 0), cA, 0, false); PG8_STAGE_A(PG8_SA(0, 1), cA, 1, false);
        if (wr == 1) PG8_BAR;
        PG8_WAIT_V(2); PG8_BAR;
        PG8_STAGE(PG8_SB(1, 0), cB + kstep, voffB); PG8_STAGE_A(PG8_SA(1, 0), cA + kstep, 0, false); PG8_STAGE(PG8_SB(1, 1), cB + hstep + kstep, voffB);
        PG8_WAIT_V(6); PG8_BAR;
    } else {
        PG8_STAGE(PG8_SB(0, 0), cB, voffB); PG8_STAGE(PG8_SA(0, 0), cA, voffA); PG8_STAGE(PG8_SB(0, 1), cB + hstep, voffB); PG8_STAGE(PG8_SA(0, 1), cA + hstep, voffA);
        if (wr == 1) PG8_BAR;
        PG8_WAIT_V(4); PG8_BAR;
        PG8_STAGE(PG8_SB(1, 0), cB + kstep, voffB); PG8_STAGE(PG8_SA(1, 0), cA + kstep, voffA); PG8_STAGE(PG8_SB(1, 1), cB + hstep + kstep, voffB);
        PG8_WAIT_V(6); PG8_BAR;
    }
    for (;;) {
        const bool has_next = S.next(ui + 1, nxt);
        const char* nA = has_next ? (const char*)g.A + (size_t)nxt.pm * tstep : cA; const char* nB = has_next ? (const char*)g.Bt + (size_t)nxt.be * g.bstride + (size_t)nxt.pn * btstep : cB;
        for (int t = 0; t < nt; t += 2) {
            const bool last = (t == nt - 2);
            const char* a1 = cA + (size_t)(t + 1) * kstep;
            const char* a2 = last ? nA : cA + (size_t)(t + 2) * kstep; const char* b2 = last ? nB : cB + (size_t)(t + 2) * kstep;
            const char* a3 = a2 + kstep; const char* b3 = b2 + kstep;
            if (last && has_next) S.a_ready(nxt);
            if constexpr (GATHER) { if (last) { const int un_ = has_next ? ui + 1 : ui; PG8_GOFF(nvA0, nvA1, un_); } }
            if constexpr (SP2) {
            PG8_LDB(B0, 0, 0); PG8_LDB(B1, 0, 1); PG8_SCHED; PG8_LDA(At, 0, 0); PG8_STAGE_A(PG8_SA(1, 1), a1, 1, false);
            PG8_WAIT_V(8); PG8_WAIT_L(0); PG8_BAR; PG8_MMA(0, 0, At, B0); PG8_MMA(0, 1, At, B1); PG8_BAR; PG8_SCHED;
            PG8_LDA(At, 0, 1); PG8_STAGE(PG8_SB(0, 0), b2, voffB); PG8_STAGE(PG8_SB(0, 1), b2 + hstep, voffB); PG8_STAGE_A(PG8_SA(0, 0), a2, 0, last);
            PG8_WAIT_V(8); PG8_WAIT_L(0); PG8_BAR; PG8_MMA(1, 0, At, B0); PG8_MMA(1, 1, At, B1); PG8_BAR; PG8_SCHED;
            PG8_LDB(B0, 1, 0); PG8_LDB(B1, 1, 1); PG8_SCHED; PG8_LDA(At, 1, 0); PG8_STAGE_A(PG8_SA(0, 1), a2, 1, last);
            PG8_WAIT_V(8); PG8_WAIT_L(0); PG8_BAR; PG8_MMA(0, 0, At, B0); PG8_MMA(0, 1, At, B1); PG8_BAR; PG8_SCHED;
            PG8_LDA(At, 1, 1); PG8_STAGE(PG8_SB(1, 0), b3, voffB); PG8_STAGE(PG8_SB(1, 1), b3 + hstep, voffB); PG8_STAGE_A(PG8_SA(1, 0), a3, 0, last);
            PG8_WAIT_V(8); PG8_WAIT_L(0); PG8_BAR; PG8_MMA(1, 0, At, B0); PG8_MMA(1, 1, At, B1); PG8_BAR; PG8_SCHED;
            } else {
            PG8_LDB(B0, 0, 0); PG8_SCHED; PG8_LDA(At, 0, 0); PG8_STAGE(PG8_SA(1, 1), a1 + hstep, voffA);
            PG8_WAIT_L(8); PG8_BAR; PG8_WAIT_L(0); PG8_MMA(0, 0, At, B0); PG8_BAR; PG8_SCHED;
            PG8_LDB(B1, 0, 1); PG8_STAGE(PG8_SB(0, 0), b2, voffB);
            PG8_BAR; PG8_WAIT_L(0); PG8_MMA(0, 1, At, B1); PG8_BAR;
            PG8_LDA(At, 0, 1); PG8_STAGE(PG8_SA(0, 0), a2, voffA);
            PG8_BAR; PG8_WAIT_L(0); PG8_MMA(1, 0, At, B0); PG8_BAR; PG8_SCHED;
            PG8_STAGE(PG8_SB(0, 1), b2 + hstep, voffB);
            PG8_WAIT_V(6); PG8_BAR; PG8_MMA(1, 1, At, B1); PG8_BAR;
            PG8_LDB(B0, 1, 0); PG8_SCHED; PG8_LDA(At, 1, 0); PG8_STAGE(PG8_SA(0, 1), a2 + hstep, voffA);
            PG8_WAIT_L(8); PG8_BAR; PG8_WAIT_L(0); PG8_MMA(0, 0, At, B0); PG8_BAR; PG8_SCHED;
            PG8_LDB(B1, 1, 1); PG8_STAGE(PG8_SB(1, 0), b3, voffB);
            PG8_BAR; PG8_WAIT_L(0); PG8_MMA(0, 1, At, B1); PG8_BAR;
            PG8_LDA(At, 1, 1); PG8_STAGE(PG8_SA(1, 0), a3, voffA);
            PG8_BAR; PG8_WAIT_L(0); PG8_MMA(1, 0, At, B0); PG8_BAR; PG8_SCHED;
            PG8_STAGE(PG8_SB(1, 1), b3 + hstep, voffB);
            PG8_WAIT_V(6); PG8_BAR; PG8_MMA(1, 1, At, B1); PG8_BAR;
            }
        }
        if constexpr (ALIGN_EPI) { if (wr == 0) PG8_BAR; }
#if PROBE_EPI2
        if constexpr (!Epi::AFTER_DRAIN) {
            int nrep_ = 1; if constexpr (Epi::IDEM) { if (E.can_repeat()) nrep_ = 2; } asm volatile("" : "+s"(nrep_));
            for (int rep_ = 0; rep_ < nrep_; ++rep_) { asm volatile("" ::: "memory");
                _Pragma("unroll") for (int a = 0; a < 2; ++a) _Pragma("unroll") for (int b = 0; b < 2; ++b) _Pragma("unroll") for (int m = 0; m < 4; ++m) _Pragma("unroll") for (int n = 0; n < 2; ++n) asm volatile("" : "+v"(acc[a][b][m][n]));
                E(acc, cur, wr, wc, fr, fq); }
            S.done(cur); }
#else
        if constexpr (!Epi::AFTER_DRAIN) { E(acc, cur, wr, wc, fr, fq); S.done(cur); }
#endif
        if (!has_next) break;
#pragma unroll
        for (int a = 0; a < 2; ++a)
#pragma unroll
            for (int b = 0; b < 2; ++b)
#pragma unroll
                for (int m = 0; m < 4; ++m)
#pragma unroll
                    for (int n = 0; n < 2; ++n) acc[a][b][m][n] = (f32x4){0.f, 0.f, 0.f, 0.f};
        cur = nxt; cA = nA; cB = nB; ++ui;
        if constexpr (GATHER) { vA0[0] = nvA0[0]; vA0[1] = nvA0[1]; vA1[0] = nvA1[0]; vA1[1] = nvA1[1]; }
        if constexpr (ALIGN_EPI) { if (wr == 1) PG8_BAR; }
    }
    PG8_WAIT_V(0);
    if constexpr (!ALIGN_EPI) { if (wr == 0) PG8_BAR; }
    PG8_BAR;
    if constexpr (Epi::AFTER_DRAIN) { E.fused(acc, cur, wr, wc, fr, fq, lds, wid, lane); S.done(cur); }
#undef PG8_GOFF
#undef PG8_STAGE_A
#undef PG8_SA
#undef PG8_SB
#undef PG8_STAGE
#undef PG8_LDA
#undef PG8_LDB
#undef PG8_MMA
#undef PG8_WAIT_V
#undef PG8_WAIT_L
#undef PG8_BAR
#undef PG8_SCHED
}
}

constexpr int D = 1024, SEQ = 16384, CTX = 256, NB = 2;
constexpr int NLAT = NB * SEQ, NCTX = NB * CTX, NROW = NLAT + NCTX;
constexpr int KEYS = CTX + SEQ;
constexpr int DIN = 2048, NEXP = 16, DEXP = 512, MOE_ROWS = 70656;
constexpr float EPS = 1e-6f, LOG2E = 1.4426950408889634f, NEGBIG = -1e30f;
constexpr int NWAVES = 8, NTHR = 512, CTXP_WGS = 16;
constexpr int N_PHASES = 18;

constexpr size_t MiB = 1u << 20;
constexpr size_t WS_CTL = 0, CTL_ZERO_BYTES = 1 * MiB;
constexpr size_t WS_MOD = 1 * MiB;
constexpr size_t WS_TABA = WS_MOD + 160 * 1024;
constexpr size_t WS_TABC = WS_TABA + 32 * 1024;
constexpr size_t WS_WSTOK = 1 * MiB + 256 * 1024;
constexpr size_t WS_HIST = 1 * MiB + 512 * 1024;
constexpr size_t WS_CNT = WS_HIST + 64 * 1024;
constexpr size_t WS_ROUTE = 2 * MiB;
constexpr size_t WS_ROWMAP = 3 * MiB;
constexpr size_t WS_WSLOT = 3 * MiB + 320 * 1024;
constexpr size_t WS_WIN = 4 * MiB, WS_WOUT = 12 * MiB, WS_WGU = 16 * MiB, WS_WD = 80 * MiB;
constexpr size_t WS_R1 = 112 * MiB, WS_R2 = 315 * MiB, WS_XS = 445 * MiB, WS_END = 510 * MiB;
constexpr size_t R1_QA = 0, R1_KA = 34078720, R1_VA = 42598400, R1_QC = 51118080, R1_KC = 68157440, R1_VC = 85196800, R1_BU = 102236160, R1_BV = 119275520;
constexpr size_t R1_H = 130 * MiB, R1_H2 = 138 * MiB, R1_HE = 0;
static_assert(R1_BV + (size_t)NROW * 256 * 2 == 130 * MiB && (size_t)MOE_ROWS * D * 2 == 138 * MiB && WS_R1 + 203 * MiB == WS_R2 && R1_H2 + (size_t)NROW * D * 2 == 203 * MiB && WS_R2 + (size_t)2 * NROW * D * 2 == WS_XS && WS_XS + (size_t)NROW * D * 2 == WS_END, "ws map");
constexpr int CW_TMO = 0, CW_BAR = 4096, CW_BND = 8192, CW_MIXQ = 9216, CW_MOEC = 32768;

constexpr int RING_BYTES = 131072, MISC_OFF = RING_BYTES + 320, TBL_OFF = RING_BYTES + 1024, GMAP_OFF = TBL_OFF + 128, GMAP_UNITS = 8, LDS_BYTES = 147456;
static_assert(GMAP_OFF + GMAP_UNITS * 1024 <= LDS_BYTES, "lds map");

#define RLX_AGENT __ATOMIC_RELAXED, __HIP_MEMORY_SCOPE_AGENT
__device__ __forceinline__ unsigned f2bf(float f) { unsigned u = __builtin_bit_cast(unsigned, f); return (u + 0x7fffu + ((u >> 16) & 1u)) >> 16; }
__device__ __forceinline__ unsigned pk2(float lo, float hi) { return pg8::cvt_pk_bf16(lo, hi); }
__device__ __forceinline__ float bf2f(unsigned short h) { return __builtin_bit_cast(float, (unsigned)h << 16); }
__device__ __forceinline__ float bflo(unsigned w) { return __builtin_bit_cast(float, w << 16); }
__device__ __forceinline__ float bfhi(unsigned w) { return __builtin_bit_cast(float, w & 0xffff0000u); }
template <int CTRL> __device__ __forceinline__ float dpp_xadd(float v) { return v + __uint_as_float(__builtin_amdgcn_update_dpp(0u, __float_as_uint(v), CTRL, 0xf, 0xf, false)); }
__device__ __forceinline__ float row16_sum(float v) {
    v = dpp_xadd<0xB1>(v); v = dpp_xadd<0x4E>(v); v = dpp_xadd<0x141>(v); v = dpp_xadd<0x140>(v); return v; }
__device__ __forceinline__ float swap16_add(float a, float b) { auto r = __builtin_amdgcn_permlane16_swap(__float_as_uint(a), __float_as_uint(b), false, false); return __uint_as_float(r[0]) + __uint_as_float(r[1]); }
__device__ __forceinline__ float swap32_add(float a, float b) { auto r = __builtin_amdgcn_permlane32_swap(__float_as_uint(a), __float_as_uint(b), false, false); return __uint_as_float(r[0]) + __uint_as_float(r[1]); }
__device__ __forceinline__ float xor32_sum(float v) { return swap32_add(v, v); }
__device__ __forceinline__ float wave_sum(float v) { v = row16_sum(v); v = swap16_add(v, v); return swap32_add(v, v); }
__device__ __forceinline__ float silu_f(float x) { return x * __builtin_amdgcn_rcpf(1.f + __expf(-x)); }
__device__ __forceinline__ float gelu_tanh(float x) { const float z = 0.7978845608028654f * (x + 0.044715f * x * x * x); return x * __builtin_amdgcn_rcpf(1.f + __expf(-2.f * z)); }

#define XB_TMO      128
#define XB_XCNT(j)  (256  + 64 * (j))
#define XB_XSUB(j)  (1280 + 64 * (j))
#define XB_XGEN(j)  (2304 + 64 * (j))
#define XB_TOP      3328
#define XB_TOPGEN   3392
#define XCD_BAR_WORDS 3456
#define XB_SPIN_CAP (1u << 22)
__device__ __forceinline__ unsigned xb_ld(unsigned* p)              { return __hip_atomic_load(p, __ATOMIC_RELAXED, __HIP_MEMORY_SCOPE_AGENT); }
__device__ __forceinline__ unsigned xb_add(unsigned* p, unsigned v) { return __hip_atomic_fetch_add(p, v, __ATOMIC_RELAXED, __HIP_MEMORY_SCOPE_AGENT); }
__device__ __forceinline__ unsigned xb_xcc_id() { return (unsigned)__builtin_amdgcn_s_getreg((3 << 11) | 20) & 0xFu; }
#define XB_SPIN(cond, bar) do { unsigned _sp = 0; while (cond) { __builtin_amdgcn_s_sleep(1); \
    if ((++_sp & 255u) == 0u) { if (xb_ld(&(bar)[XB_TMO])) break; if (_sp > XB_SPIN_CAP) { atomicAdd(&(bar)[XB_TMO], 1u); break; } } } } while (0)
struct XcdBarrier { unsigned* bar; unsigned x; volatile LAS unsigned* st; };
__device__ __forceinline__ XcdBarrier xcd_barrier_post(unsigned* bar, volatile LAS unsigned* st) {
    XcdBarrier b; b.bar = bar; b.x = xb_xcc_id(); b.st = st;
    if (threadIdx.x == 0) (void)xb_add(&bar[XB_XCNT(b.x)], 1u);
    return b;
}
__device__ __forceinline__ void xcd_barrier_complete(unsigned* bar, unsigned x, unsigned& nloc, unsigned& nx) {
    const unsigned G = gridDim.x * gridDim.y * gridDim.z;
    unsigned sum, cnt, mine, sp = 0u;
    for (;;) {
        sum = 0u; cnt = 0u; mine = 0u;
#pragma unroll
        for (unsigned j = 0; j < 16; ++j) { const unsigned c = xb_ld(&bar[XB_XCNT(j)]); sum += c; cnt += (c > 0u) ? 1u : 0u; mine = (j == x) ? c : mine; }
        if (sum == G) break;
        __builtin_amdgcn_s_sleep(1);
        if ((++sp & 255u) == 0u) { if (xb_ld(&bar[XB_TMO])) break; if (sp > XB_SPIN_CAP) { atomicAdd(&bar[XB_TMO], 1u); break; } }
    }
    nloc = mine > 0u ? mine : 1u; nx = cnt > 0u ? cnt : 1u;
}
__device__ __forceinline__ void xcd_barrier(const XcdBarrier& b) {
    asm volatile("s_waitcnt vmcnt(0)" ::: "memory");
    __syncthreads();
    if (threadIdx.x == 0) {
        unsigned* bar = b.bar;
        __builtin_amdgcn_s_waitcnt(0);
        unsigned nloc = b.st[0], nx = b.st[1];
        if (nloc == 0u) { xcd_barrier_complete(bar, b.x, nloc, nx); b.st[0] = nloc; b.st[1] = nx; }
        const unsigned old = xb_add(&bar[XB_XSUB(b.x)], 1u);
        const unsigned gen = old / nloc;
        if (old + 1u == (gen + 1u) * nloc) {
            __builtin_amdgcn_fence(__ATOMIC_RELEASE, "agent");
            asm volatile("s_waitcnt vmcnt(0)" ::: "memory");
            const unsigned og = xb_add(&bar[XB_TOP], 1u);
            const unsigned tg = og / nx;
            if (og + 1u == (tg + 1u) * nx) xb_add(&bar[XB_TOPGEN], 1u);
            else XB_SPIN(xb_ld(&bar[XB_TOPGEN]) == tg, bar);
            __builtin_amdgcn_fence(__ATOMIC_ACQUIRE, "agent");
            xb_add(&bar[XB_XGEN(b.x)], 1u);
            asm volatile("s_waitcnt vmcnt(0)" ::: "memory");
        } else {
            XB_SPIN(xb_ld(&bar[XB_XGEN(b.x)]) == gen, bar);
            __builtin_amdgcn_fence(__ATOMIC_ACQUIRE, "agent");
            asm volatile("s_waitcnt vmcnt(0)" ::: "memory");
        }
    }
    __syncthreads();
}

struct Frame {
    LAS unsigned char* lds;
    int tid, lane, wave, G, bid;
    float* out; unsigned char* ws;
};
#define INP(i) ((const float*)((const GAS float* const __attribute__((address_space(4)))*)__builtin_amdgcn_kernarg_segment_ptr())[i])
enum { I_X = 0, I_C, I_CTX, I_CCTX, I_WADA, I_BADA, I_GMIX, I_WIN, I_SINK, I_WSTOK, I_BSTOK, I_GTOK, I_LQ1, I_LK1, I_LQ2, I_LK2, I_GSUB, I_WOUT, I_GFFN, I_WRG, I_BRG, I_WRE, I_BRE, I_WGATE, I_WUP, I_WDOWN, I_GFINAL };

__device__ __forceinline__ bf16_t* xs_row(const Frame& F, int r) { return (bf16_t*)(F.ws + WS_XS) + (size_t)r * D; }
__device__ __forceinline__ const float* xin_row(const Frame& F, int r) { return r < NLAT ? INP(I_X) + (size_t)r * D : INP(I_CTX) + (size_t)(r - NLAT) * D; }
__device__ __forceinline__ int mod_w(int r) { return r < NLAT ? (r >> 14) : 2; }
__device__ __forceinline__ const float* mod_ptr(const Frame& F, int l, int w, int chunk) { return (const float*)(F.ws + WS_MOD) + ((size_t)(l * 3 + w) * 6 + chunk) * D; }

__device__ __forceinline__ int rope_perm(int j, int ptype) {
    if (ptype == 1) return (j >> 1) + 16 * (j & 1);
    if (ptype == 2) return j < 16 ? (j >> 1) + 8 * (j & 1) : 16 + ((j - 16) >> 1) + 8 * (j & 1);
    return j;
}
struct P0Item { const float* src; bf16_t* dst; int K, N, ptype; };
constexpr int IT_IN = 2 * 16 * 64, IT_OUT = 2 * 16 * 32, IT_G = 32 * 256, IT_U = 32 * 256, IT_D = 32 * 256;
constexpr int P0_NITEMS = IT_IN + IT_OUT + IT_G + IT_U + IT_D;
#ifndef P0_DEFER
#define P0_DEFER 0
#endif
constexpr int P0_EARLY = P0_DEFER ? IT_IN / 2 : P0_NITEMS;
constexpr int CV_PER_UNIT = 64;
constexpr int CV_UNITS = (P0_NITEMS - P0_EARLY) / CV_PER_UNIT;
static_assert((P0_NITEMS - P0_EARLY) % CV_PER_UNIT == 0, "conversion units");
__device__ __forceinline__ P0Item p0_decode(const Frame& F, int it) {
    P0Item q; int r = it;
    if (r < IT_IN) { const int l = r >> 10, x = r & 1023, kb = x >> 6, nb = x & 63, n0 = nb * 32;
        q.ptype = n0 < 640 ? 1 : ((n0 >= 1280 && n0 < 1792) ? 2 : 0); q.K = D; q.N = DIN;
        q.src = INP(I_WIN) + (size_t)l * D * DIN + (size_t)(kb * 64) * DIN + n0; q.dst = (bf16_t*)(F.ws + WS_WIN) + ((size_t)l * DIN + n0) * D + kb * 64; return q; }
    r -= IT_IN;
    if (r < IT_OUT) { const int l = r >> 9, x = r & 511, kb = x >> 5, nb = x & 31, n0 = nb * 32;
        q.ptype = 0; q.K = D; q.N = D;
        q.src = INP(I_WOUT) + (size_t)l * D * D + (size_t)(kb * 64) * D + n0; q.dst = (bf16_t*)(F.ws + WS_WOUT) + ((size_t)l * D + n0) * D + kb * 64; return q; }
    r -= IT_OUT;
    if (r < IT_G + IT_U) { const int up = r >= IT_G; if (up) r -= IT_G; const int idx = r >> 8, x = r & 255, kb = x >> 4, nb = x & 15, n0 = nb * 32;
        const int drow = (n0 >> 7) * 256 + (n0 & 127) + (up ? 128 : 0);
        q.ptype = 0; q.K = D; q.N = DEXP;
        q.src = (up ? INP(I_WUP) : INP(I_WGATE)) + (size_t)idx * D * DEXP + (size_t)(kb * 64) * DEXP + n0; q.dst = (bf16_t*)(F.ws + WS_WGU) + ((size_t)idx * 1024 + drow) * D + kb * 64; return q; }
    r -= IT_G + IT_U;
    { const int idx = r >> 8, x = r & 255, kb = x >> 5, nb = x & 31, n0 = nb * 32;
        q.ptype = 0; q.K = DEXP; q.N = D;
        q.src = INP(I_WDOWN) + (size_t)idx * DEXP * D + (size_t)(kb * 64) * D + n0; q.dst = (bf16_t*)(F.ws + WS_WD) + ((size_t)idx * D + n0) * DEXP + kb * 64; return q; }
}
__device__ __forceinline__ void p0_load(const P0Item& q, float (&v)[32], int lane) {
#pragma unroll
    for (int i = 0; i < 32; ++i) v[i] = q.src[(size_t)(2 * i + (lane >> 5)) * q.N + (lane & 31)];
}
__device__ __forceinline__ void p0_lds_write(const float (&v)[32], LAS float* scr, int lane) {
#pragma unroll
    for (int i = 0; i < 32; ++i) scr[(2 * i + (lane >> 5)) * 33 + (lane & 31)] = v[i];
}
__device__ __forceinline__ void p0_finish(const P0Item& q, LAS float* scr, int lane) {
    asm volatile("s_waitcnt lgkmcnt(0)" ::: "memory");
    const int c = lane & 7;
#pragma unroll
    for (int j = 0; j < 4; ++j) { const int n = (lane >> 3) + 8 * j; const LAS float* s = scr + (8 * c) * 33 + rope_perm(n, q.ptype);
        u32x4 o; o.x = pk2(s[0 * 33], s[1 * 33]); o.y = pk2(s[2 * 33], s[3 * 33]); o.z = pk2(s[4 * 33], s[5 * 33]); o.w = pk2(s[6 * 33], s[7 * 33]);
        *(u32x4*)(q.dst + (size_t)n * q.K + 8 * c) = o; }
    asm volatile("s_waitcnt lgkmcnt(0)" ::: "memory");
}
__device__ __forceinline__ void p0_items(const Frame& F, int it0, int stride, int n, LAS float* scr, int lane) {
    if (n <= 0) return;
    float v[32];
    P0Item cur = p0_decode(F, it0);
    p0_load(cur, v, lane);
    for (int j = 0; j < n; ++j) {
        p0_lds_write(v, scr, lane);
        P0Item nxt = cur;
        if (j + 1 < n) { nxt = p0_decode(F, it0 + (j + 1) * stride); p0_load(nxt, v, lane); }
        p0_finish(cur, scr, lane);
        cur = nxt;
    }
}
__device__ __forceinline__ void p0_prologue(Frame& F) {
    LAS float* scr = (LAS float*)(F.lds + F.wave * 16384);
    { const int gwr = (F.G - 1 - F.bid) * NWAVES + F.wave, NGW = F.G * NWAVES;
      p0_items(F, gwr, NGW, gwr < P0_EARLY ? (P0_EARLY - gwr + NGW - 1) / NGW : 0, scr, F.lane); }
    __syncthreads();
    for (int it = F.bid; it < 2 * 96; it += F.G) {
        const int l = it / 96, n = (it % 96) * 64 + F.lane;
        const float* wa = INP(I_WADA) + (size_t)l * D * 6144 + n;
        const int kb = F.wave * 128;
        float s0[2], s1[2], s2[2];
#pragma unroll
        for (int h = 0; h < 2; ++h) { s0[h] = silu_f(INP(I_C)[kb + 64 * h + F.lane]); s1[h] = silu_f(INP(I_C)[D + kb + 64 * h + F.lane]); s2[h] = silu_f(INP(I_CCTX)[kb + 64 * h + F.lane]); }
        float a0 = 0.f, a1 = 0.f, a2 = 0.f;
#pragma unroll
        for (int kk = 0; kk < 2; ++kk) { float w[64];
#pragma unroll
            for (int i = 0; i < 64; ++i) w[i] = wa[(size_t)(kb + kk * 64 + i) * 6144];
            __builtin_amdgcn_sched_barrier(0);
#pragma unroll
            for (int i = 0; i < 64; ++i) {
                a0 += __int_as_float(__builtin_amdgcn_readlane(__float_as_int(s0[kk]), i)) * w[i];
                a1 += __int_as_float(__builtin_amdgcn_readlane(__float_as_int(s1[kk]), i)) * w[i];
                a2 += __int_as_float(__builtin_amdgcn_readlane(__float_as_int(s2[kk]), i)) * w[i]; } }
        LAS float* part = (LAS float*)(F.lds + F.wave * 16384 + 12288);
        part[F.lane] = a0; part[64 + F.lane] = a1; part[128 + F.lane] = a2;
        __syncthreads();
        if (F.wave < 3) { float s = INP(I_BADA)[l * 6144 + n];
#pragma unroll
            for (int w = 0; w < 8; ++w) s += ((LAS float*)(F.lds + w * 16384 + 12288))[F.wave * 64 + F.lane];
            ((float*)(F.ws + WS_MOD))[(size_t)(l * 3 + F.wave) * 6144 + n] = s; }
        __syncthreads();
    }
    const int gt = F.bid * NTHR + F.tid, NGT = F.G * NTHR;
    for (int i = gt; i < 256 * 16 + 256 * 8; i += NGT) {
        if (i < 4096) { const int pos = i >> 4, j = i & 15; const double ang = (double)pos * pow(10000.0, -(double)j / 16.0);
            ((f32x2*)(F.ws + WS_TABA))[i] = (f32x2){(float)cos(ang), (float)sin(ang)}; }
        else { const int q = i - 4096, pos = q >> 3, j = q & 7; const double ang = (double)pos * pow(10000.0, -(double)j / 8.0);
            ((f32x2*)(F.ws + WS_TABC))[q] = (f32x2){(float)cos(ang), (float)sin(ang)}; }
    }
    for (int i = gt; i < 2 * 4 * 128 * 128; i += NGT) ((bf16_t*)(F.ws + WS_WSTOK))[i] = (bf16_t)f2bf(INP(I_WSTOK)[i]);
}

template <int MODE>
__device__ __forceinline__ void norm_phase(Frame& F, int l) {
    const int gw = F.bid * NWAVES + F.wave, NGW = F.G * NWAVES;
    bf16_t* H = (bf16_t*)(F.ws + WS_R1 + R1_H);
    const bf16_t* YE = (const bf16_t*)(F.ws + WS_R2);
    const int lp = (MODE == 2) ? 1 : 0, M = (MODE == 2) ? NLAT : NROW;
    int wcur = -1; f32x4 A[4], B[4], G[4], GF[4];
    if (MODE == 2) { const f32x4* g = (const f32x4*)INP(I_GFINAL) + F.lane;
#pragma unroll
        for (int j = 0; j < 4; ++j) GF[j] = g[64 * j]; }
    for (int rb = gw * 4; rb < M; rb += NGW * 4) {
        const int w = mod_w(rb);
        if (w != wcur) { wcur = w;
            if (MODE != 0) { const f32x4* gt2 = (const f32x4*)mod_ptr(F, lp, w, 5) + F.lane;
#pragma unroll
                for (int j = 0; j < 4; ++j) G[j] = gt2[64 * j]; }
            if (MODE != 2) { const f32x4* g = (const f32x4*)(INP(I_GMIX) + l * D) + F.lane; const f32x4* sh = (const f32x4*)mod_ptr(F, l, w, 0) + F.lane; const f32x4* sc = (const f32x4*)mod_ptr(F, l, w, 1) + F.lane;
#pragma unroll
                for (int j = 0; j < 4; ++j) { A[j] = g[64 * j] * (1.f + sc[64 * j]); B[j] = sh[64 * j]; } } }
        f32x4 v[4][4];
        if (MODE == 0) {
#pragma unroll
            for (int t = 0; t < 4; ++t) { const f32x4* s = (const f32x4*)xin_row(F, rb + t) + F.lane;
#pragma unroll
                for (int j = 0; j < 4; ++j) v[t][j] = s[64 * j]; }
        } else {
            u32x2 ya[4][4], yb[4][4], xq[4][4];
#pragma unroll
            for (int t = 0; t < 4; ++t) { const int r = rb + t; const u32x2* s = (const u32x2*)xs_row(F, r) + F.lane;
                const u32x2* y0 = (const u32x2*)(YE + (size_t)(2 * r) * D) + F.lane; const u32x2* y1 = (const u32x2*)(YE + (size_t)(2 * r + 1) * D) + F.lane;
#pragma unroll
                for (int j = 0; j < 4; ++j) { xq[t][j] = s[64 * j]; ya[t][j] = y0[64 * j]; yb[t][j] = y1[64 * j]; } }
#pragma unroll
            for (int t = 0; t < 4; ++t) { const int r = rb + t;
#pragma unroll
                for (int j = 0; j < 4; ++j) { const u32x2 a = ya[t][j], b = yb[t][j], x = xq[t][j];
                    f32x4 y; y.x = bflo(a.x) + bflo(b.x); y.y = bfhi(a.x) + bfhi(b.x); y.z = bflo(a.y) + bflo(b.y); y.w = bfhi(a.y) + bfhi(b.y);
                    v[t][j] = (f32x4){hflo(x.x), hfhi(x.x), hflo(x.y), hfhi(x.y)} + G[j] * y; }
                if (MODE == 1) { bf16_t* xr = xs_row(F, r);
#pragma unroll
                    for (int j = 0; j < 4; ++j) ((u32x2*)xr + F.lane)[64 * j] = (u32x2){cvt_pk_f16(v[t][j].x, v[t][j].y), cvt_pk_f16(v[t][j].z, v[t][j].w)}; } }
        }
        float ss[4];
#pragma unroll
        for (int t = 0; t < 4; ++t) { float s = 0.f;
#pragma unroll
            for (int j = 0; j < 4; ++j) s += (v[t][j].x * v[t][j].x + v[t][j].y * v[t][j].y) + (v[t][j].z * v[t][j].z + v[t][j].w * v[t][j].w);
            ss[t] = s; }
#pragma unroll
        for (int t = 0; t < 4; ++t) ss[t] = wave_sum(ss[t]);
#pragma unroll
        for (int t = 0; t < 4; ++t) { const int r = rb + t; const float rinv = 1.0f / sqrtf(ss[t] * (1.f / D) + EPS);
            if (MODE == 2) { f32x4* o = (f32x4*)(F.out + (size_t)r * D) + F.lane;
#pragma unroll
                for (int j = 0; j < 4; ++j) o[64 * j] = v[t][j] * (GF[j] * rinv); }
            else { u32x2* o = (u32x2*)(H + (size_t)r * D) + F.lane;
#pragma unroll
                for (int j = 0; j < 4; ++j) { const f32x4 h = v[t][j] * (A[j] * rinv) + B[j]; o[64 * j] = (u32x2){pk2(h.x, h.y), pk2(h.z, h.w)}; } } }
    }
}

typedef const f32x4 (&AccRef)[2][2][4][2];

__device__ __forceinline__ void st_wt16(void* p, u32x4 v) { asm volatile("global_store_dwordx4 %0, %1, off sc0 sc1\n\ts_nop 1" :: "v"((GAS void*)p), "v"(v) : "memory"); }
#ifndef PROBE_ST2
#define PROBE_ST2 0
#endif
#ifndef EPIPROJ_WT
#define EPIPROJ_WT 0
#endif
struct EpiProj {
    static constexpr bool PERM = true, AFTER_DRAIN = false, IDEM = true;
    __device__ __forceinline__ bool can_repeat() const { return true; }
    unsigned char* r1; const f32x2* tabA; const f32x2* tabC; unsigned* bnd;
    static __device__ __forceinline__ void rot4(f32x4& v0, f32x4& v1, const f32x2* tb, float sc) {
        const f32x4 t0 = *(const f32x4*)tb, t1 = *(const f32x4*)(tb + 2);
        f32x4 a, b;
        a.x = v0.x * t0.x - v0.y * t0.y; a.y = v0.x * t0.y + v0.y * t0.x; a.z = v0.z * t0.z - v0.w * t0.w; a.w = v0.z * t0.w + v0.w * t0.z;
        b.x = v1.x * t1.x - v1.y * t1.y; b.y = v1.x * t1.y + v1.y * t1.x; b.z = v1.z * t1.z - v1.w * t1.w; b.w = v1.z * t1.w + v1.w * t1.z;
        v0 = a * sc; v1 = b * sc;
    }
    static __device__ __forceinline__ void rot4r(f32x4& v0, f32x4& v1, const f32x4 t0, const f32x4 t1, float sc) {
        f32x4 a, b;
        a.x = v0.x * t0.x - v0.y * t0.y; a.y = v0.x * t0.y + v0.y * t0.x; a.z = v0.z * t0.z - v0.w * t0.w; a.w = v0.z * t0.w + v0.w * t0.z;
        b.x = v1.x * t1.x - v1.y * t1.y; b.y = v1.x * t1.y + v1.y * t1.x; b.z = v1.z * t1.z - v1.w * t1.w; b.w = v1.z * t1.w + v1.w * t1.z;
        v0 = a * sc; v1 = b * sc;
    }
    template <int KIND, int RS>
    static __device__ __forceinline__ void run(AccRef acc, bf16_t* base0, bf16_t* base1, const f32x4 (&T0)[4], const f32x4 (&T1)[4], bool usep, float sc, unsigned* w0, unsigned* w1) {
        float mxv[2] = {0.f, 0.f};
#pragma unroll
        for (int ai = 0; ai < 2; ++ai) {
            float sq[2][4];
#pragma unroll
            for (int m = 0; m < 4; ++m) {
                f32x4 t0 = T0[0], t1 = T1[0];
                if (KIND != 2) {
#pragma unroll
                    for (int e = 0; e < 4; ++e) { t0[e] = usep ? T0[ai][e] : T0[m][e]; t1[e] = usep ? T1[ai][e] : T1[m][e]; } }
#pragma unroll
                for (int bj = 0; bj < 2; ++bj) {
                    const bool rot = KIND == 0 || (KIND == 1 && bj == 0);
                    f32x4 v0 = acc[ai][bj][m][0], v1 = acc[ai][bj][m][1];
                    if (rot) rot4r(v0, v1, t0, t1, sc);
                    u32x4 w; w.x = pg8::cvt_pk_bf16(v0.x, v0.y); w.y = pg8::cvt_pk_bf16(v0.z, v0.w); w.z = pg8::cvt_pk_bf16(v1.x, v1.y); w.w = pg8::cvt_pk_bf16(v1.z, v1.w);
                    if (EPIPROJ_WT) st_wt16((bj ? base1 : base0) + (size_t)(ai * 128 + m * 16) * RS, w); else *(u32x4*)((bj ? base1 : base0) + (size_t)(ai * 128 + m * 16) * RS) = w;
#if PROBE_ST2
                    asm volatile("" : "+v"(w) :: "memory"); *(u32x4*)((bj ? base1 : base0) + (size_t)(ai * 128 + m * 16) * RS) = w;
#endif
                    if (rot) sq[bj][m] = (v0.x * v0.x + v0.y * v0.y) + (v0.z * v0.z + v0.w * v0.w) + (v1.x * v1.x + v1.y * v1.y) + (v1.z * v1.z + v1.w * v1.w);
                }
                __builtin_amdgcn_sched_barrier(0);
            }
#pragma unroll
            for (int bj = 0; bj < 2; ++bj) if (KIND == 0 || (KIND == 1 && bj == 0))
                mxv[bj] = fmaxf(mxv[bj], swap32_add(swap16_add(sq[bj][0], sq[bj][1]), swap16_add(sq[bj][2], sq[bj][3])));
            __builtin_amdgcn_sched_barrier(0);
        }
#pragma unroll
        for (int bj = 0; bj < 2; ++bj) if (KIND == 0 || (KIND == 1 && bj == 0)) {
            float mw = mxv[bj];
#pragma unroll
            for (int o = 1; o < 64; o <<= 1) mw = fmaxf(mw, __shfl_xor(mw, o));
            if ((threadIdx.x & 63) == 0) atomicMax(bj ? w1 : w0, __float_as_uint(mw)); }
    }
    __device__ __forceinline__ void operator()(AccRef acc, const pg8::Unit& u, int wr, int wc, int fr_in, int fq_in) const {
        int fr = fr_in, fq = fq_in; asm volatile("" : "+v"(fr), "+v"(fq));
        const int pn = u.pn, b = u.pm >> 6, tl0 = (u.pm & 63) * 256, hw = wc >> 1, wl = wc & 1;
        constexpr float QSA = 0.125f * LOG2E, QSC = 0.17677669529663687f * LOG2E;
        const int pos0 = CTX + tl0 + wr * 64 + fr, dc = wl * 32 + fq * 8;
        const bool ropeA = pn <= 2, ropeC = (pn == 5) || (pn == 6);
        const bool usep = ropeA ? (wl == 0) : (fq < 2);
        f32x4 T0[4], T1[4];
        { const f32x2* tb = ropeA ? tabA : tabC; const int strd = ropeA ? 16 : 8, col = ropeA ? 4 * fq : 4 * (fq & 1);
          const int prow0 = (tl0 >> 6) + wr;
#pragma unroll
          for (int sl = 0; sl < 4; ++sl) { const int row = usep ? prow0 + 2 * (sl & 1) : 16 * sl + fr; const f32x2* e = tb + (size_t)row * strd + col;
              if (ropeA || ropeC) { T0[sl] = *(const f32x4*)e; T1[sl] = *(const f32x4*)(e + 2); } else { T0[sl] = (f32x4){1.f, 0.f, 1.f, 0.f}; T1[sl] = T0[sl]; } } }
        if (pn <= 1) {
            bf16_t* q = (bf16_t*)(r1 + R1_QA); unsigned* w = bnd + 32 + b * 16 + (pn * 4 + hw) * 2 + wl;
            run<0, 64>(acc, q + (((size_t)(b * 8 + pn * 4 + hw) * KEYS + pos0) * 64 + dc), q + (((size_t)(b * 8 + pn * 4 + 2 + hw) * KEYS + pos0) * 64 + dc), T0, T1, usep, QSA, w, w + 4);
        } else if (pn == 2) {
            const size_t o = ((size_t)(b * 2 + hw) * KEYS + pos0) * 64 + dc;
            run<1, 64>(acc, (bf16_t*)(r1 + R1_KA) + o, (bf16_t*)(r1 + R1_VA) + o, T0, T1, usep, 1.f, bnd + 64 + b * 4 + hw * 2 + wl, nullptr);
        } else if (pn == 5 || pn == 6) {
            bf16_t* q = (bf16_t*)(r1 + (pn == 5 ? R1_QC : R1_KC)); unsigned* w = bnd + (pn == 5 ? 0 : 16) + b * 8 + hw * 2 + wl;
            run<0, 64>(acc, q + (((size_t)(b * 4 + hw) * KEYS + pos0) * 64 + dc), q + (((size_t)(b * 4 + 2 + hw) * KEYS + pos0) * 64 + dc), T0, T1, usep, pn == 5 ? QSC : 1.f, w, w + 4);
        } else if (pn == 7) {
            bf16_t* q = (bf16_t*)(r1 + R1_VC);
            run<2, 64>(acc, q + (((size_t)(b * 4 + hw) * KEYS + pos0) * 64 + dc), q + (((size_t)(b * 4 + 2 + hw) * KEYS + pos0) * 64 + dc), T0, T1, usep, 1.f, nullptr, nullptr);
        } else {
            bf16_t* q = (bf16_t*)(r1 + (pn == 3 ? R1_BU : R1_BV)) + (size_t)(u.pm * 256 + wr * 64 + fr) * 256 + wc * 32 + fq * 8;
            run<2, 256>(acc, q, q + 128, T0, T1, usep, 1.f, nullptr, nullptr);
        }
    }
};

struct EpiOut {
    static constexpr bool PERM = true, AFTER_DRAIN = false, IDEM = true;
    __device__ __forceinline__ bool can_repeat() const { return xin != nullptr; }
    const float* xin;
    bf16_t* xs; const float* modl;
    template <bool F32SRC>
    __device__ __forceinline__ void body(AccRef acc, const pg8::Unit& u, int wr, int wc, int fr, int fq) const {
        const int r0 = u.pm * 256, w = r0 >> 14, cb = u.pn * 256 + wc * 32 + fq * 8;
        const float* gt = modl + (size_t)w * 6144 + 2 * D;
        f32x4 g[2][2];
#pragma unroll
        for (int bj = 0; bj < 2; ++bj)
#pragma unroll
            for (int n = 0; n < 2; ++n) g[bj][n] = *(const f32x4*)(gt + cb + bj * 128 + 4 * n);
        const size_t ro0 = (size_t)(r0 + wr * 64 + fr) * D + cb;
        if (F32SRC) {
#pragma unroll
            for (int ai = 0; ai < 2; ++ai) { f32x4 xv[4][2][2];
#pragma unroll
                for (int m = 0; m < 4; ++m)
#pragma unroll
                    for (int bj = 0; bj < 2; ++bj) { const float* p = xin + ro0 + (size_t)(ai * 128 + m * 16) * D + bj * 128; xv[m][bj][0] = *(const f32x4*)p; xv[m][bj][1] = *(const f32x4*)(p + 4); }
                asm volatile("" ::: "memory");
#pragma unroll
                for (int m = 0; m < 4; ++m)
#pragma unroll
                    for (int bj = 0; bj < 2; ++bj) { const f32x4 x0 = xv[m][bj][0] + g[bj][0] * acc[ai][bj][m][0], x1 = xv[m][bj][1] + g[bj][1] * acc[ai][bj][m][1];
                        u32x4 o; o.x = cvt_pk_f16(x0.x, x0.y); o.y = cvt_pk_f16(x0.z, x0.w); o.z = cvt_pk_f16(x1.x, x1.y); o.w = cvt_pk_f16(x1.z, x1.w);
                        *(u32x4*)(xs + ro0 + (size_t)(ai * 128 + m * 16) * D + bj * 128) = o; }
                asm volatile("" ::: "memory"); }
        } else {
            u32x4 xb[2][4][2];
#pragma unroll
            for (int ai = 0; ai < 2; ++ai)
#pragma unroll
                for (int m = 0; m < 4; ++m)
#pragma unroll
                    for (int bj = 0; bj < 2; ++bj) xb[ai][m][bj] = *(const u32x4*)(xs + ro0 + (size_t)(ai * 128 + m * 16) * D + bj * 128);
            asm volatile("" ::: "memory");
#pragma unroll
            for (int ai = 0; ai < 2; ++ai)
#pragma unroll
                for (int m = 0; m < 4; ++m)
#pragma unroll
                    for (int bj = 0; bj < 2; ++bj) { const u32x4 q = xb[ai][m][bj];
                        const f32x4 x0 = (f32x4){hflo(q.x), hfhi(q.x), hflo(q.y), hfhi(q.y)} + g[bj][0] * acc[ai][bj][m][0], x1 = (f32x4){hflo(q.z), hfhi(q.z), hflo(q.w), hfhi(q.w)} + g[bj][1] * acc[ai][bj][m][1];
                        u32x4 o; o.x = cvt_pk_f16(x0.x, x0.y); o.y = cvt_pk_f16(x0.z, x0.w); o.z = cvt_pk_f16(x1.x, x1.y); o.w = cvt_pk_f16(x1.z, x1.w);
                        *(u32x4*)(xs + ro0 + (size_t)(ai * 128 + m * 16) * D + bj * 128) = o; }
        }
    }
    __device__ __forceinline__ void operator()(AccRef acc, const pg8::Unit& u, int wr, int wc, int fr_in, int fq_in) const {
        int fr = fr_in, fq = fq_in; asm volatile("" : "+v"(fr), "+v"(fq));
        if (xin) body<true>(acc, u, wr, wc, fr, fq); else body<false>(acc, u, wr, wc, fr, fq);
    }
};

struct EpiMoe1 {
    static constexpr bool PERM = true, AFTER_DRAIN = false, IDEM = true;
    __device__ __forceinline__ bool can_repeat() const { return true; }
    bf16_t* HE;
    __device__ __forceinline__ void operator()(AccRef acc, const pg8::Unit& u, int wr, int wc, int fr_in, int fq_in) const {
        int fr = fr_in, fq = fq_in; asm volatile("" : "+v"(fr), "+v"(fq));
#pragma unroll
        for (int ai = 0; ai < 2; ++ai)
#pragma unroll
            for (int m = 0; m < 4; ++m) { const int r = u.pm * 256 + ai * 128 + wr * 64 + m * 16 + fr;
                const f32x4 g0 = acc[ai][0][m][0], g1 = acc[ai][0][m][1], u0 = acc[ai][1][m][0], u1 = acc[ai][1][m][1];
                u32x4 w; w.x = pg8::cvt_pk_bf16(silu_f(g0.x) * u0.x, silu_f(g0.y) * u0.y); w.y = pg8::cvt_pk_bf16(silu_f(g0.z) * u0.z, silu_f(g0.w) * u0.w);
                w.z = pg8::cvt_pk_bf16(silu_f(g1.x) * u1.x, silu_f(g1.y) * u1.y); w.w = pg8::cvt_pk_bf16(silu_f(g1.z) * u1.z, silu_f(g1.w) * u1.w);
                st_wt16(HE + (size_t)r * DEXP + u.pn * 128 + wc * 32 + fq * 8, w); }
    }
};
struct EpiMoe2 {
    static constexpr bool PERM = true, AFTER_DRAIN = false, IDEM = true;
    __device__ __forceinline__ bool can_repeat() const { return true; }
    bf16_t* YE; const int* rowmap; const float* wslot;
    __device__ __forceinline__ void operator()(AccRef acc, const pg8::Unit& u, int wr, int wc, int fr_in, int fq_in) const {
        int fr = fr_in, fq = fq_in; asm volatile("" : "+v"(fr), "+v"(fq));
        int drs[2][4]; float wss[2][4];
#pragma unroll
        for (int ai = 0; ai < 2; ++ai)
#pragma unroll
            for (int m = 0; m < 4; ++m) { const int r = u.pm * 256 + ai * 128 + wr * 64 + m * 16 + fr; drs[ai][m] = rowmap[r]; wss[ai][m] = wslot[r]; }
        asm volatile("" ::: "memory");
#pragma unroll
        for (int ai = 0; ai < 2; ++ai)
#pragma unroll
            for (int m = 0; m < 4; ++m) { const int dr = drs[ai][m]; const float ws = wss[ai][m];
                if (dr >= 0) {
#pragma unroll
                    for (int bj = 0; bj < 2; ++bj) { const f32x4 a = acc[ai][bj][m][0] * ws, b = acc[ai][bj][m][1] * ws;
                        u32x4 w; w.x = pg8::cvt_pk_bf16(a.x, a.y); w.y = pg8::cvt_pk_bf16(a.z, a.w); w.z = pg8::cvt_pk_bf16(b.x, b.y); w.w = pg8::cvt_pk_bf16(b.z, b.w);
                        *(u32x4*)(YE + (size_t)dr * D + u.pn * 256 + bj * 128 + wc * 32 + fq * 8) = w; } } }
    }
};
struct OneUnit { int pm, pn;
    __device__ __forceinline__ bool next(int i, pg8::Unit& u) const { if (i > 0) return false; u.pm = pm; u.pn = pn; u.be = 0; return true; }
    __device__ __forceinline__ void a_ready(const pg8::Unit&) const {}
    __device__ __forceinline__ void done(const pg8::Unit&) const {}
};
struct GroupedOrder {
    int nN, G, c, total; const LAS int* tbase; unsigned* cnt;
    __device__ __forceinline__ bool next(int i, pg8::Unit& u) const {
        int L;
        if (G == 256 && nN == 4) { const int x = c & 7, y = c >> 3; L = (i * 64 + x * 8 + (y >> 2)) * 4 + (y & 3); } else L = i * G + c;
        if (L >= total) return false;
        const int pm = L / nN, pn = L - pm * nN; int e = 0;
#pragma unroll
        for (int k = 1; k < NEXP; ++k) e += (pm >= tbase[k]) ? 1 : 0;
        u.pm = __builtin_amdgcn_readfirstlane(pm); u.pn = __builtin_amdgcn_readfirstlane(pn); u.be = __builtin_amdgcn_readfirstlane(e); return true;
    }
    __device__ __forceinline__ void a_ready(const pg8::Unit&) const {}
    __device__ __forceinline__ void done(const pg8::Unit& u) const {
        if (cnt) { asm volatile("s_waitcnt vmcnt(0)" ::: "memory");
            if ((threadIdx.x & 63) == 0) __hip_atomic_fetch_add(cnt + 16 * u.pm, 1u, __ATOMIC_RELAXED, __HIP_MEMORY_SCOPE_AGENT); } }
};
struct GroupedOrder2 {
    int G, c, total; const LAS int* tbase; unsigned* cnt;
    __device__ __forceinline__ bool next(int i, pg8::Unit& u) const {
        int L;
        const int rf = total / 256, rem = total - rf * 256, nl = 256 - rem;
        if (G == 256 && rf >= 1 && 2 * rem <= nl) { const int x = c & 7, y = c >> 3, rho = 255 - ((x * 8 + (y >> 2)) * 4 + (y & 3));
            if (i < rf - 1) L = i * 256 + rho;
            else { const int e = i - (rf - 1); if (rho >= nl) return false; L = (rf - 1) * 256 + e * nl + rho; } }
        else L = i * G + (G - 1 - c);
        if (L >= total) return false;
        const int pm = L >> 2, pn = L & 3; int e = 0;
#pragma unroll
        for (int k = 1; k < NEXP; ++k) e += (pm >= tbase[k]) ? 1 : 0;
        u.pm = __builtin_amdgcn_readfirstlane(pm); u.pn = __builtin_amdgcn_readfirstlane(pn); u.be = __builtin_amdgcn_readfirstlane(e); return true;
    }
    __device__ __forceinline__ void a_ready(const pg8::Unit& u) const {
        if (__builtin_amdgcn_readfirstlane((int)(threadIdx.x >> 6)) == 0) { unsigned sp = 0;
            while (__hip_atomic_load(cnt + 16 * u.pm, __ATOMIC_RELAXED, __HIP_MEMORY_SCOPE_AGENT) < 32u) { __builtin_amdgcn_s_sleep(2); if (++sp > (1u << 24)) break; }
            __builtin_amdgcn_fence(__ATOMIC_ACQUIRE, "agent"); asm volatile("s_waitcnt vmcnt(0) lgkmcnt(0)" ::: "memory"); }
        asm volatile("" ::: "memory"); __builtin_amdgcn_s_barrier(); asm volatile("" ::: "memory");
    }
    __device__ __forceinline__ void done(const pg8::Unit&) const {}
};
__device__ __forceinline__ void load_tile_bases(Frame& F, int l, LAS int* tb) {
    if (F.tid == 0) { const int* cnt = (const int*)(F.ws + WS_CNT) + l * NEXP; int acc = 0;
        for (int e = 0; e < NEXP; ++e) { tb[e] = acc; acc += (cnt[e] + 255) >> 8; } tb[NEXP] = acc; }
    __syncthreads();
}


typedef float f32x4_t __attribute__((ext_vector_type(4)));
template <class Epi>
__device__ __forceinline__ void ctx_gemm(Frame& F, const bf16_t* H  , const bf16_t* Wt  , int N, const Epi& E) {
    int tid_l = threadIdx.x; asm volatile("" : "+v"(tid_l));
    const int lane = tid_l & 63, wv = __builtin_amdgcn_readfirstlane(tid_l >> 6), tok = lane & 15, g = lane >> 4;
    const int ncb = N / 32, ntiles = (NCTX / 16) * ncb;
    for (int wt = F.bid * NWAVES + wv; wt < ntiles; wt += F.G * NWAVES) {
        const int tm = wt / ncb, c0 = (wt - tm * ncb) * 32;
        const bf16_t* hp = H + (size_t)(tm * 16 + tok) * D + 8 * g;
        const bf16_t* wp = Wt + (size_t)(c0 + tok) * D + 8 * g;
        f32x4_t acc0 = {0.f, 0.f, 0.f, 0.f}, acc1 = {0.f, 0.f, 0.f, 0.f};
#pragma unroll 8
        for (int ks = 0; ks < D / 32; ++ks) { const bf16x8 hf = *(const bf16x8*)(hp + ks * 32), w0 = *(const bf16x8*)(wp + ks * 32), w1 = *(const bf16x8*)(wp + (size_t)16 * D + ks * 32);
            acc0 = __builtin_amdgcn_mfma_f32_16x16x32_bf16(w0, hf, acc0, 0, 0, 0); acc1 = __builtin_amdgcn_mfma_f32_16x16x32_bf16(w1, hf, acc1, 0, 0, 0); }
        E(tm * 16 + tok, c0, g, acc0, acc1);
    }
}
struct CtxEpiProj {
    unsigned char* r1; unsigned* bnd;
    __device__ __forceinline__ void operator()(int rc, int c0, int g, f32x4_t a0, f32x4_t a1) const {
        constexpr float QSA = 0.125f * LOG2E, QSC = 0.17677669529663687f * LOG2E;
        const int b = rc >> 8, pos = rc & 255, r = NLAT + rc, pn = c0 >> 8, cc0 = c0 & 255;
        float sc = 1.f; if (pn <= 1) sc = QSA; else if (pn == 5) sc = QSC;
        a0 = a0 * sc; a1 = a1 * sc;
        const bool track = (pn <= 1) || (pn == 2 && cc0 < 128) || pn == 5 || pn == 6;
#pragma unroll
        for (int cb = 0; cb < 2; ++cb) { const f32x4_t v = cb ? a1 : a0; const int cc = cc0 + 16 * cb + 4 * g; bf16_t* dst;
            if (pn <= 1) dst = (bf16_t*)(r1 + R1_QA) + (((size_t)(b * 8 + pn * 4 + (cc >> 6)) * KEYS + pos) * 64 + (cc & 63));
            else if (pn == 2) dst = (bf16_t*)(r1 + (cc < 128 ? R1_KA : R1_VA)) + (((size_t)(b * 2 + ((cc & 127) >> 6)) * KEYS + pos) * 64 + (cc & 63));
            else if (pn == 3) dst = (bf16_t*)(r1 + R1_BU) + ((size_t)r * 256 + cc);
            else if (pn == 4) dst = (bf16_t*)(r1 + R1_BV) + ((size_t)r * 256 + cc);
            else dst = (bf16_t*)(r1 + (pn == 5 ? R1_QC : (pn == 6 ? R1_KC : R1_VC))) + (((size_t)(b * 4 + (cc >> 6)) * KEYS + pos) * 64 + (cc & 63));
            *(u32x2*)dst = (u32x2){pg8::cvt_pk_bf16(v.x, v.y), pg8::cvt_pk_bf16(v.z, v.w)}; }
        if (track) {
            float ss = (a0.x * a0.x + a0.y * a0.y) + (a0.z * a0.z + a0.w * a0.w) + (a1.x * a1.x + a1.y * a1.y) + (a1.z * a1.z + a1.w * a1.w);
            ss = swap16_add(ss, ss); ss = swap32_add(ss, ss);
            float m = ss; m = fmaxf(m, __shfl_xor(m, 1)); m = fmaxf(m, __shfl_xor(m, 2)); m = fmaxf(m, __shfl_xor(m, 4)); m = fmaxf(m, __shfl_xor(m, 8));
            const int half = (cc0 >> 5) & 1; int word;
            if (pn <= 1) word = 32 + b * 16 + (pn * 4 + (cc0 >> 6)) * 2 + half;
            else if (pn == 2) word = 64 + b * 4 + (cc0 >> 6) * 2 + half;
            else word = (pn == 5 ? 0 : 16) + b * 8 + (cc0 >> 6) * 2 + half;
            if ((threadIdx.x & 63) == 0) atomicMax(bnd + word, __float_as_uint(m)); }
    }
};
struct CtxEpiOut {
    const float* src; bf16_t* dst; const float* gt;
    __device__ __forceinline__ void operator()(int rc, int c0, int g, f32x4_t a0, f32x4_t a1) const {
#pragma unroll
        for (int cb = 0; cb < 2; ++cb) { const int c = c0 + 16 * cb + 4 * g; const f32x4_t v = cb ? a1 : a0;
            const f32x4_t x = *(const f32x4_t*)(src + (size_t)rc * D + c), gg = *(const f32x4_t*)(gt + c);
            const f32x4_t y = x + gg * v;
            *(u32x2*)(dst + (size_t)rc * D + c) = (u32x2){cvt_pk_f16(y[0], y[1]), cvt_pk_f16(y[2], y[3])}; }
    }
};

struct ModCache { int w; f32x4 A[4], B[4]; };
__device__ __forceinline__ void route_group(Frame& F, int l, LAS float* RW, LAS int* hist, f32x4 (&v)[4][4], int rb, int nr, ModCache& mc) {
    bf16_t* H2 = (bf16_t*)(F.ws + WS_R1 + R1_H2);
    const int trow = F.lane >> 4;
    float ss[4];
#pragma unroll
    for (int t = 0; t < 4; ++t) { float s = 0.f;
#pragma unroll
        for (int j = 0; j < 4; ++j) s += (v[t][j].x * v[t][j].x + v[t][j].y * v[t][j].y) + (v[t][j].z * v[t][j].z + v[t][j].w * v[t][j].w);
        ss[t] = s; }
#pragma unroll
    for (int t = 0; t < 4; ++t) ss[t] = wave_sum(ss[t]);
#pragma unroll
    for (int t = 0; t < 4; ++t) { const int r = rb + (t < nr ? t : 0), w = mod_w(r); const float rinv = 1.0f / sqrtf(ss[t] * (1.f / D) + EPS);
        if (w != mc.w) { mc.w = w;
            const f32x4* g = (const f32x4*)(INP(I_GFFN) + l * D) + F.lane; const f32x4* sh = (const f32x4*)mod_ptr(F, l, w, 3) + F.lane; const f32x4* sc = (const f32x4*)mod_ptr(F, l, w, 4) + F.lane;
#pragma unroll
            for (int j = 0; j < 4; ++j) { mc.A[j] = g[64 * j] * (1.f + sc[64 * j]); mc.B[j] = sh[64 * j]; } }
        u32x2* o = (u32x2*)(H2 + (size_t)r * D) + F.lane;
#pragma unroll
        for (int j = 0; j < 4; ++j) { const f32x4 h = v[t][j] * (mc.A[j] * rinv) + mc.B[j]; v[t][j] = h; if (t < nr) o[64 * j] = (u32x2){pk2(h.x, h.y), pk2(h.z, h.w)}; } }
    float lg[4][4];
#pragma unroll
    for (int t = 0; t < 4; ++t)
#pragma unroll
        for (int c = 0; c < 4; ++c) lg[t][c] = 0.f;
#pragma unroll
    for (int j = 0; j < 4; ++j)
#pragma unroll
        for (int i = 0; i < 4; ++i) { const f32x4 wq = *(const LAS f32x4*)(RW + (size_t)((j * 4 + i) * 64 + F.lane) * 20);
#pragma unroll
            for (int t = 0; t < 4; ++t) { const float hv = v[t][j][i]; lg[t][0] += hv * wq.x; lg[t][1] += hv * wq.y; lg[t][2] += hv * wq.z; lg[t][3] += hv * wq.w; } }
    const float* brg = INP(I_BRG) + l * 4; const float* bre = INP(I_BRE) + l * 16;
    float gl[4];
#pragma unroll
    for (int c = 0; c < 4; ++c) { const float w0 = swap32_add(lg[0][c], lg[2][c]), w1 = swap32_add(lg[1][c], lg[3][c]); gl[c] = row16_sum(swap16_add(w0, w1)) + brg[c]; }
    int gsel = 0; float gm = gl[0];
#pragma unroll
    for (int c = 1; c < 4; ++c) if (gl[c] > gm) { gm = gl[c]; gsel = c; }
    float gs = 0.f;
#pragma unroll
    for (int c = 0; c < 4; ++c) gs += __expf(gl[c] - gm);
    const float ptop = 1.f / gs;
    int gr[4];
#pragma unroll
    for (int t = 0; t < 4; ++t) gr[t] = __builtin_amdgcn_readlane(gsel, 16 * t);
    float lx[4][4];
#pragma unroll
    for (int t = 0; t < 4; ++t)
#pragma unroll
        for (int c = 0; c < 4; ++c) lx[t][c] = 0.f;
#pragma unroll
    for (int j = 0; j < 4; ++j)
#pragma unroll
        for (int i = 0; i < 4; ++i) { const LAS float* rwb = RW + (size_t)((j * 4 + i) * 64 + F.lane) * 20 + 4;
#pragma unroll
            for (int t = 0; t < 4; ++t) { const f32x4 wq = *(const LAS f32x4*)(rwb + 4 * gr[t]); const float hv = v[t][j][i];
                lx[t][0] += hv * wq.x; lx[t][1] += hv * wq.y; lx[t][2] += hv * wq.z; lx[t][3] += hv * wq.w; } }
    float le[4];
#pragma unroll
    for (int c = 0; c < 4; ++c) { const float w0 = swap32_add(lx[0][c], lx[2][c]), w1 = swap32_add(lx[1][c], lx[3][c]); le[c] = row16_sum(swap16_add(w0, w1)) + bre[4 * gsel + c]; }
    int i0 = 0; float m0 = le[0];
#pragma unroll
    for (int j = 1; j < 4; ++j) if (le[j] > m0) { m0 = le[j]; i0 = j; }
    int i1 = -1; float m1 = -3.4e38f;
#pragma unroll
    for (int j = 0; j < 4; ++j) if (j != i0 && le[j] > m1) { m1 = le[j]; i1 = j; }
    const float ex = __expf(m1 - m0), w0 = ptop / (1.f + ex), w1 = ptop * ex / (1.f + ex);
    const int e0 = gsel * 4 + i0, e1 = gsel * 4 + i1;
    if ((F.lane & 15) == 0 && trow < nr) { int* ro = (int*)(F.ws + WS_ROUTE) + (size_t)(rb + trow) * 4; ro[0] = e0; ro[1] = e1; ((float*)ro)[2] = w0; ((float*)ro)[3] = w1;
        atomicAdd((int*)hist + e0, 1); atomicAdd((int*)hist + e1, 1); }
}
__device__ __forceinline__ void route_phase(Frame& F, int l, int M) {
    LAS float* RW = (LAS float*)F.lds;
    LAS int* hist = (LAS int*)(F.lds + 81920);
    { const float* wrg = INP(I_WRG) + (size_t)l * D * 4; const float* wre = INP(I_WRE) + (size_t)l * D * 16;
#pragma unroll
      for (int m = 0; m < 2; ++m) { const int c = F.tid + NTHR * m; const int slot = ((c >> 8) * 4 + (c & 3)) * 64 + ((c >> 2) & 63);
          LAS f32x4* d = (LAS f32x4*)(RW + slot * 20); d[0] = *(const f32x4*)(wrg + c * 4);
#pragma unroll
          for (int q = 0; q < 4; ++q) d[1 + q] = *(const f32x4*)(wre + c * 16 + 4 * q); } }
    if (F.tid < NEXP) hist[F.tid] = 0;
    __syncthreads();
    const int RPW = (M + F.G - 1) / F.G, r0 = F.bid * RPW, nrows = max(0, min(RPW, M - r0));
#define RT_LOAD(V, gq_) do { const int rb_ = r0 + (gq_) * 4, nr_ = min(4, nrows - (gq_) * 4); \
        _Pragma("unroll") for (int t = 0; t < 4; ++t) { const u32x2* s_ = (const u32x2*)xs_row(F, rb_ + (t < nr_ ? t : 0)) + F.lane; \
            _Pragma("unroll") for (int j = 0; j < 4; ++j) V[t][j] = s_[64 * j]; } } while (0)
#define RT_EXPAND(V) do { _Pragma("unroll") for (int t = 0; t < 4; ++t) _Pragma("unroll") for (int j = 0; j < 4; ++j) vx[t][j] = (f32x4){hflo(V[t][j].x), hfhi(V[t][j].x), hflo(V[t][j].y), hfhi(V[t][j].y)}; } while (0)
    u32x2 vA[4][4], vB[4][4]; f32x4 vx[4][4]; ModCache mc; mc.w = -1;
    int gq = F.wave;
    if (gq * 4 < nrows) RT_LOAD(vA, gq);
    while (gq * 4 < nrows) {
        const bool h1 = (gq + NWAVES) * 4 < nrows;
        if (h1) RT_LOAD(vB, gq + NWAVES);
        RT_EXPAND(vA); route_group(F, l, RW, hist, vx, r0 + gq * 4, min(4, nrows - gq * 4), mc);
        gq += NWAVES; if (!h1) break;
        const bool h2 = (gq + NWAVES) * 4 < nrows;
        if (h2) RT_LOAD(vA, gq + NWAVES);
        RT_EXPAND(vB); route_group(F, l, RW, hist, vx, r0 + gq * 4, min(4, nrows - gq * 4), mc);
        gq += NWAVES; if (!h2) break;
    }
#undef RT_LOAD
#undef RT_EXPAND
    __syncthreads();
    if (F.tid < NEXP) ((int*)(F.ws + WS_HIST))[(size_t)(l * 256 + F.bid) * NEXP + F.tid] = hist[F.tid];
}

__device__ __forceinline__ void permute_phase(Frame& F, int l, int M) {
    LAS int* cnt = (LAS int*)F.lds; LAS int* base = cnt + 16; LAS int* wgoff = base + 32; LAS int* eids = wgoff + 16; LAS int* slots = eids + 1024;
    const int* HIST = (const int*)(F.ws + WS_HIST) + (size_t)l * 256 * NEXP;
    const int RPW = (M + F.G - 1) / F.G, r0 = F.bid * RPW, nrows = max(0, min(RPW, M - r0)), nitems = 2 * nrows;
    const int* ROUTE = (const int*)(F.ws + WS_ROUTE);
    if (F.tid < NEXP) { int tot = 0, before = 0; for (int g = 0; g < F.G; ++g) { const int h = HIST[g * NEXP + F.tid]; tot += h; before += (g < F.bid) ? h : 0; } cnt[F.tid] = tot; wgoff[F.tid] = before; }
    for (int i = F.tid; i < nitems; i += NTHR) eids[i] = ROUTE[(size_t)(r0 + (i >> 1)) * 4 + (i & 1)];
    __syncthreads();
    if (F.tid == 0) { int acc = 0; for (int e = 0; e < NEXP; ++e) { base[e] = acc; acc += (cnt[e] + 255) & ~255; } base[NEXP] = acc;
        if (F.bid == 0) { int* c = (int*)(F.ws + WS_CNT) + l * NEXP; for (int e = 0; e < NEXP; ++e) c[e] = cnt[e]; } }
    __syncthreads();
    for (int e = F.wave * 2; e < F.wave * 2 + 2; ++e) { int running = base[e] + wgoff[e];
        for (int c0 = 0; c0 < nitems; c0 += 64) { const int i = c0 + F.lane; const bool mt = (i < nitems) && (eids[i] == e);
            const unsigned long long bal = __ballot(mt); const int rank = __popcll(bal & ((1ull << F.lane) - 1ull));
            if (mt) slots[i] = running + rank; running += __popcll(bal); } }
    __syncthreads();
    int* ROWMAP = (int*)(F.ws + WS_ROWMAP); float* WSLOT = (float*)(F.ws + WS_WSLOT);
    for (int i = F.tid; i < nitems; i += NTHR) { const int slot = slots[i], r = r0 + (i >> 1), k = i & 1;
        ROWMAP[slot] = 2 * r + k; WSLOT[slot] = ((const float*)ROUTE)[(size_t)r * 4 + 2 + k]; }
    const int gt = F.bid * NTHR + F.tid, NGT = F.G * NTHR;
    for (int e = 0; e < NEXP; ++e) { const int p0 = base[e] + cnt[e], np = base[e + 1] - p0;
        for (int p = gt; p < np; p += NGT) { ROWMAP[p0 + p] = -1; WSLOT[p0 + p] = 0.f; } }
}

__device__ __forceinline__ int crow(int r, int hi) { return (r & 3) + 8 * (r >> 2) + 4 * hi; }
typedef short v4i16_t __attribute__((ext_vector_type(4)));
__device__ __forceinline__ s16x4 vtr(const LAS unsigned char* p) { return __builtin_bit_cast(s16x4, __builtin_amdgcn_ds_read_tr16_b64_v4i16((LAS v4i16_t*)p)); }

template <int NMAP>
__device__ __forceinline__ void attn_unit(LAS unsigned char* lds, const bf16_t* qw, const bf16_t* Kb, const bf16_t* Vb, int ta_lo, int ta_n, int tb_lo, int tb_n,
                                          int qlat, float m_init, float l_init, f32x16 (&o)[NMAP][2], float (&lsum)[NMAP]) {
    int tid_l = threadIdx.x; asm volatile("" : "+v"(tid_l));
    const int tid = tid_l, lane = tid & 63, r32 = lane & 31, hi = lane >> 5;
    const int skey = tid >> 3, sch = tid & 7;
    const int kst = skey * 128 + ((sch ^ ((skey >> 1) & 7)) << 4);
    const int vst = 16384 + (sch >> 2) * 4096 + (skey >> 4) * 1024 + (skey & 15) * 64 + (sch & 3) * 16;
    const size_t goff = (size_t)skey * 64 + sch * 8;
    const int vrd = 16384 + ((lane >> 4) & 1) * 32 + (lane & 3) * 8 + (4 * hi + ((lane & 15) >> 2)) * 64;
    bf16x8 qr[4];
#pragma unroll
    for (int s = 0; s < 4; ++s) qr[s] = *(const bf16x8*)(qw + (size_t)r32 * 64 + s * 16 + hi * 8);
    float mrun[NMAP];
#pragma unroll
    for (int mp = 0; mp < NMAP; ++mp) { mrun[mp] = m_init; lsum[mp] = l_init; o[mp][0] = f32x16{}; o[mp][1] = f32x16{}; }
    const int ntile = ta_n + tb_n;
    u32x4 kreg, vreg;
    { const int T = (ta_n > 0) ? ta_lo : tb_lo; kreg = *(const u32x4*)(Kb + (size_t)T * 4096 + goff); vreg = *(const u32x4*)(Vb + (size_t)T * 4096 + goff); }
    *(LAS u32x4*)(lds + kst) = kreg; *(LAS u32x4*)(lds + vst) = vreg;
    __syncthreads();
    for (int t = 0; t < ntile; ++t) {
        const int cur = (t & 1) * 8192;
        if (t + 1 < ntile) { const int T = (t + 1 < ta_n) ? ta_lo + t + 1 : tb_lo + (t + 1 - ta_n); kreg = *(const u32x4*)(Kb + (size_t)T * 4096 + goff); vreg = *(const u32x4*)(Vb + (size_t)T * 4096 + goff); }
#pragma unroll
        for (int mp = 0; mp < NMAP; ++mp) {
            f32x16 S[2];
#pragma unroll
            for (int kb = 0; kb < 2; ++kb) { const int key = kb * 32 + r32; const LAS unsigned char* kp = lds + cur + key * 128; const int sw = (key >> 1) & 7;
                f32x16 a = f32x16{};
                constexpr int NS = (NMAP == 1) ? 4 : 2;
#pragma unroll
                for (int s = 0; s < NS; ++s) { const int sq = (NMAP == 1) ? s : 2 * mp + s; const bf16x8 kf = *(const LAS bf16x8*)(kp + (((2 * sq + hi) ^ sw) << 4));
                    a = __builtin_amdgcn_mfma_f32_32x32x16_bf16(kf, qr[sq], a, 0, 0, 0); }
                S[kb] = a; }
            if (NMAP == 1 && qlat >= 0 && t >= ta_n) { const int kl0 = (tb_lo + (t - ta_n) - 4) * 64;
#pragma unroll
                for (int kb = 0; kb < 2; ++kb)
#pragma unroll
                    for (int r = 0; r < 16; ++r) { const int dlt = kl0 + kb * 32 + crow(r, hi) - qlat; if (dlt > 128 || dlt < -128) S[kb][r] = NEGBIG; } }
            float rm = S[0][0];
#pragma unroll
            for (int r = 1; r < 16; ++r) rm = fmaxf(rm, S[0][r]);
#pragma unroll
            for (int r = 0; r < 16; ++r) rm = fmaxf(rm, S[1][r]);
            rm = fmaxf(rm, __shfl_xor(rm, 32));
            if (__any(rm > mrun[mp] + 8.f)) { const float mn = fmaxf(mrun[mp], rm), al = __builtin_amdgcn_exp2f(mrun[mp] - mn); mrun[mp] = mn; lsum[mp] *= al; o[mp][0] = o[mp][0] * al; o[mp][1] = o[mp][1] * al; }
            float ps = 0.f;
#pragma unroll
            for (int kb = 0; kb < 2; ++kb)
#pragma unroll
                for (int r = 0; r < 16; ++r) { const float p = __builtin_amdgcn_exp2f(S[kb][r] - mrun[mp]); S[kb][r] = p; ps += p; }
            lsum[mp] += ps;
#pragma unroll
            for (int kb = 0; kb < 2; ++kb)
#pragma unroll
                for (int s2 = 0; s2 < 2; ++s2) { const int ks = 2 * kb + s2;
                    u32x4 pw; pw.x = pg8::cvt_pk_bf16(S[kb][8 * s2 + 0], S[kb][8 * s2 + 1]); pw.y = pg8::cvt_pk_bf16(S[kb][8 * s2 + 2], S[kb][8 * s2 + 3]);
                    pw.z = pg8::cvt_pk_bf16(S[kb][8 * s2 + 4], S[kb][8 * s2 + 5]); pw.w = pg8::cvt_pk_bf16(S[kb][8 * s2 + 6], S[kb][8 * s2 + 7]);
                    const bf16x8 pf = __builtin_bit_cast(bf16x8, pw);
#pragma unroll
                    for (int d0 = 0; d0 < 2; ++d0) { const s16x4 lo = vtr(lds + cur + vrd + d0 * 4096 + ks * 1024), hh = vtr(lds + cur + vrd + d0 * 4096 + ks * 1024 + 512);
                        const bf16x8 vf = (bf16x8){lo[0], lo[1], lo[2], lo[3], hh[0], hh[1], hh[2], hh[3]};
                        o[mp][d0] = __builtin_amdgcn_mfma_f32_32x32x16_bf16(vf, pf, o[mp][d0], 0, 0, 0); } }
            __builtin_amdgcn_sched_barrier(0);
        }
        if (t + 1 < ntile) { *(LAS u32x4*)(lds + (cur ^ 8192) + kst) = kreg; *(LAS u32x4*)(lds + (cur ^ 8192) + vst) = vreg; }
        __syncthreads();
    }
#pragma unroll
    for (int mp = 0; mp < NMAP; ++mp) lsum[mp] = xor32_sum(lsum[mp]);
}


__device__ __forceinline__ void glds16(const void* gsrc, unsigned lds_dst) { unsigned keep;
    asm volatile("s_mov_b32 %0, m0\n\ts_mov_b32 m0, %2\n\ts_nop 0\n\tglobal_load_lds_dwordx4 %1, off\n\ts_mov_b32 m0, %0" : "=&s"(keep) : "v"(gsrc), "s"(lds_dst) : "memory"); }

__device__ __forceinline__ float dot2_ones(unsigned w, float acc) { const pg8::bf16x2_t one = {(__bf16)1.0f, (__bf16)1.0f}; return __builtin_amdgcn_fdot2_f32_bf16(__builtin_bit_cast(pg8::bf16x2_t, w), one, acc, false); }
#ifndef PROBE_A2
#define PROBE_A2 0
#endif
#ifndef A_LEAD
#define A_LEAD 4
#endif
#ifndef AF_SMPRIO
#define AF_SMPRIO 0
#endif
#ifndef AF_PVPRIO
#define AF_PVPRIO 0
#endif
#ifndef AF_PRIO
#define AF_PRIO 0
#endif
#ifndef PROBE_EXP
#define PROBE_EXP 0
#endif
#ifndef PROBE_MFMA
#define PROBE_MFMA 0
#endif
#ifndef PROBE_NOSTAG
#define PROBE_NOSTAG 0
#endif
#if PROBE_EXP
#define AF_PROBE_EXP(a, b, c, d) do { const float q0_ = __builtin_amdgcn_exp2f((a) * 0.5f), q1_ = __builtin_amdgcn_exp2f((b) * 0.5f), q2_ = __builtin_amdgcn_exp2f((c) * 0.5f), q3_ = __builtin_amdgcn_exp2f((d) * 0.5f); asm volatile("" :: "v"(q0_), "v"(q1_), "v"(q2_), "v"(q3_)); } while (0)
#else
#define AF_PROBE_EXP(a, b, c, d) do {} while (0)
#endif
#if PROBE_MFMA
#define AF_PROBE_MFMA(v0, v1, p) do { dmy = __builtin_amdgcn_mfma_f32_32x32x16_bf16(v0, p, dmy, 0, 0, 0); dmy = __builtin_amdgcn_mfma_f32_32x32x16_bf16(v1, p, dmy, 0, 0, 0); } while (0)
#else
#define AF_PROBE_MFMA(v0, v1, p) do {} while (0)
#endif
template <int NMAP, bool PRE = false, int PRE_ST = 0, int LEAD = 2>
__device__ __forceinline__ void attn_fast(LAS unsigned char* lds, const bf16_t* qw, const bf16_t* Kb, const bf16_t* Vb, int ta_lo, int ta_n, int tb_lo, int tb_n,
                                          int qlat, float l_init, f32x16 (&o)[NMAP][2], float (&lsum)[NMAP], bf16x8 (&qr)[4]) {
    int tid_l = threadIdx.x; asm volatile("" : "+v"(tid_l));
    const int tid = tid_l, lane = tid & 63, r32 = lane & 31, hi = lane >> 5, wid = __builtin_amdgcn_readfirstlane(tid >> 6);
    const bool lead = PROBE_NOSTAG ? true : (wid < 4);
    const int kkey = wid * 8 + (lane >> 3), kc = (lane & 7) ^ ((kkey >> 1) & 7);
    const size_t ksrc = (size_t)kkey * 64 + kc * 8;
    const size_t vsrc = (size_t)(16 * (wid & 3) + (lane >> 2)) * 64 + 32 * (wid >> 2) + (lane & 3) * 8;
    const int vrd = 8192 + ((lane >> 4) & 1) * 32 + (lane & 3) * 8 + (4 * hi + ((lane & 15) >> 2)) * 64;
    const int krd0 = r32 * 128, ksw0 = (r32 >> 1) & 7;
    if (!PRE) {
#pragma unroll
        for (int s = 0; s < 4; ++s) qr[s] = *(const bf16x8*)(qw + (size_t)r32 * 64 + s * 16 + hi * 8); }
    const int ntile = ta_n + tb_n;
#define AF_TILE(t) ((t) < ta_n ? ta_lo + (t) : tb_lo + (t) - ta_n)
#define AF_DMA(t) do { const int T_ = AF_TILE(t); const unsigned so_ = lds0 + (unsigned)(((t) & (2 * LEAD - 1)) * 16384 + wid * 1024); \
        glds16(Kb + (size_t)T_ * 4096 + ksrc, (unsigned)__builtin_amdgcn_readfirstlane(so_)); \
        glds16(Vb + (size_t)T_ * 4096 + vsrc, (unsigned)__builtin_amdgcn_readfirstlane(so_ + 8192u)); } while (0)
    const unsigned lds0 = (unsigned)(uintptr_t)lds;
    static_assert(!PRE || LEAD == 2, "af_begin requests two tiles");
    if (!PRE) { _Pragma("unroll") for (int k = 0; k < LEAD; ++k) if (k < ntile) AF_DMA(k); }
#pragma unroll
    for (int s = 0; s < 4; ++s) asm volatile("" : "+v"(qr[s]));
#pragma unroll
    for (int mp = 0; mp < NMAP; ++mp) { lsum[mp] = l_init; o[mp][0] = f32x16{}; o[mp][1] = f32x16{}; }
    bf16x8 pf[NMAP][4];
    f32x16 dmy = f32x16{};
#define AF_QKSM(sl, t) do { if (AF_SMPRIO) __builtin_amdgcn_s_setprio(1); float ps0[NMAP], ps1[NMAP], ps2[NMAP], ps3[NMAP]; \
        _Pragma("unroll") for (int mp = 0; mp < NMAP; ++mp) { ps0[mp] = 0.f; ps1[mp] = 0.f; ps2[mp] = 0.f; ps3[mp] = 0.f; } \
        _Pragma("unroll") for (int kb = 0; kb < 2; ++kb) { f32x16 S[NMAP]; const LAS unsigned char* kp = lds + (sl) + kb * 4096 + krd0; bf16x8 kf[4]; \
            _Pragma("unroll") for (int s = 0; s < 4; ++s) kf[s] = *(const LAS bf16x8*)(kp + (((2 * s + hi) ^ ksw0) << 4)); \
            if (NMAP == 1) { f32x16 a = f32x16{}; _Pragma("unroll") for (int s = 0; s < 4; ++s) a = __builtin_amdgcn_mfma_f32_32x32x16_bf16(kf[s], qr[s], a, 0, 0, 0); S[0] = a; } \
            else { f32x16 a = f32x16{}, b = f32x16{}; \
                a = __builtin_amdgcn_mfma_f32_32x32x16_bf16(kf[0], qr[0], a, 0, 0, 0); a = __builtin_amdgcn_mfma_f32_32x32x16_bf16(kf[1], qr[1], a, 0, 0, 0); \
                b = __builtin_amdgcn_mfma_f32_32x32x16_bf16(kf[2], qr[2], b, 0, 0, 0); b = __builtin_amdgcn_mfma_f32_32x32x16_bf16(kf[3], qr[3], b, 0, 0, 0); \
                S[0] = a; S[NMAP - 1] = b; } \
            if (NMAP == 1 && qlat >= 0 && (t) >= ta_n) { const int kl0 = (tb_lo + ((t) - ta_n) - 4) * 64; \
                if ((kl0 >> 7) != (__builtin_amdgcn_readfirstlane(qlat) >> 7)) { const int db = kl0 + kb * 32 + 4 * hi - qlat; \
                _Pragma("unroll") for (int r = 0; r < 16; ++r) { const int dlt = db + (r & 3) + 8 * (r >> 2); if (dlt > 128 || dlt < -128) S[0][r] = NEGBIG; } } } \
            _Pragma("unroll") for (int mp = 0; mp < NMAP; ++mp) { \
                _Pragma("unroll") for (int r = 0; r < 16; r += 4) { const float p0 = __builtin_amdgcn_exp2f(S[mp][r]), p1 = __builtin_amdgcn_exp2f(S[mp][r + 1]), p2 = __builtin_amdgcn_exp2f(S[mp][r + 2]), p3 = __builtin_amdgcn_exp2f(S[mp][r + 3]); \
                    ps0[mp] += p0; ps1[mp] += p1; ps2[mp] += p2; ps3[mp] += p3; S[mp][r] = p0; S[mp][r + 1] = p1; S[mp][r + 2] = p2; S[mp][r + 3] = p3; } \
                _Pragma("unroll") for (int s2 = 0; s2 < 2; ++s2) { u32x4 pw; pw.x = pg8::cvt_pk_bf16(S[mp][8 * s2 + 0], S[mp][8 * s2 + 1]); pw.y = pg8::cvt_pk_bf16(S[mp][8 * s2 + 2], S[mp][8 * s2 + 3]); \
                    pw.z = pg8::cvt_pk_bf16(S[mp][8 * s2 + 4], S[mp][8 * s2 + 5]); pw.w = pg8::cvt_pk_bf16(S[mp][8 * s2 + 6], S[mp][8 * s2 + 7]); pf[mp][2 * kb + s2] = __builtin_bit_cast(bf16x8, pw); } } } \
        _Pragma("unroll") for (int mp = 0; mp < NMAP; ++mp) lsum[mp] += (ps0[mp] + ps1[mp]) + (ps2[mp] + ps3[mp]); if (AF_SMPRIO) __builtin_amdgcn_s_setprio(0); } while (0)
#define AF_PV(sl) do { if (AF_PVPRIO) __builtin_amdgcn_s_setprio(1); _Pragma("unroll") for (int ks = 0; ks < 4; ++ks) { bf16x8 vf[2]; \
            _Pragma("unroll") for (int d0 = 0; d0 < 2; ++d0) { const s16x4 lo = vtr(lds + (sl) + vrd + d0 * 4096 + ks * 1024), hh = vtr(lds + (sl) + vrd + d0 * 4096 + ks * 1024 + 512); \
                vf[d0] = (bf16x8){lo[0], lo[1], lo[2], lo[3], hh[0], hh[1], hh[2], hh[3]}; } \
            _Pragma("unroll") for (int mp = 0; mp < NMAP; ++mp) { o[mp][0] = __builtin_amdgcn_mfma_f32_32x32x16_bf16(vf[0], pf[mp][ks], o[mp][0], 0, 0, 0); \
                o[mp][1] = __builtin_amdgcn_mfma_f32_32x32x16_bf16(vf[1], pf[mp][ks], o[mp][1], 0, 0, 0); AF_PROBE_MFMA(vf[0], vf[1], pf[mp][ks]); } } if (AF_PVPRIO) __builtin_amdgcn_s_setprio(0); } while (0)
#define AF_TOP(t) do { if (PRE && (t) < 2 && (t) + 1 < ntile) { static_assert(!PRE || PRE_ST == 8 || PRE_ST == 4 || PRE_ST == 0, "PRE_ST"); \
            if (PRE_ST == 8) asm volatile("s_waitcnt vmcnt(10)" ::: "memory"); else if (PRE_ST == 4) asm volatile("s_waitcnt vmcnt(6)" ::: "memory"); else asm volatile("s_waitcnt vmcnt(2)" ::: "memory"); } \
        else { const int ahead_ = min(LEAD - 1, ntile - 1 - (t));                 \
            if (ahead_ >= 3) asm volatile("s_waitcnt vmcnt(6)" ::: "memory"); else if (ahead_ == 2) asm volatile("s_waitcnt vmcnt(4)" ::: "memory"); \
            else if (ahead_ == 1) asm volatile("s_waitcnt vmcnt(2)" ::: "memory"); else asm volatile("s_waitcnt vmcnt(0)" ::: "memory"); } \
        __builtin_amdgcn_s_barrier(); asm volatile("" ::: "memory"); __builtin_amdgcn_sched_barrier(0); if ((t) + LEAD < ntile) AF_DMA((t) + LEAD); __builtin_amdgcn_sched_barrier(0); } while (0)
#define AF_NEXT(t) do { __builtin_amdgcn_sched_barrier(0); } while (0)
    if (AF_PRIO && lead) __builtin_amdgcn_s_setprio(1);
    if (lead) {
        for (int t = 0; t < ntile; ++t) { AF_TOP(t); const int sl = (t & (2 * LEAD - 1)) * 16384;
            AF_QKSM(sl, t); AF_PV(sl); AF_NEXT(t); }
    } else {
        { AF_TOP(0); AF_QKSM(0, 0); AF_NEXT(0); }
        for (int t = 1; t < ntile; ++t) { AF_TOP(t); const int sl = (t & (2 * LEAD - 1)) * 16384, slp = ((t - 1) & (2 * LEAD - 1)) * 16384;
            AF_PV(slp); __builtin_amdgcn_sched_barrier(0); AF_QKSM(sl, t); AF_NEXT(t); }
        { const int slp = ((ntile - 1) & (2 * LEAD - 1)) * 16384; AF_PV(slp); }
    }
#undef AF_TOP
#undef AF_NEXT
    if (AF_PRIO && lead) __builtin_amdgcn_s_setprio(0);
    if (PROBE_MFMA) asm volatile("" :: "v"(dmy));
    asm volatile("s_waitcnt lgkmcnt(0)" ::: "memory");
    __builtin_amdgcn_s_barrier();
    asm volatile("" ::: "memory");
#pragma unroll
    for (int mp = 0; mp < NMAP; ++mp) lsum[mp] = xor32_sum(lsum[mp]);
#undef AF_TILE
#undef AF_DMA
#undef AF_QKSM
#undef AF_PV
}

__device__ __forceinline__ void af_begin(LAS unsigned char* lds, const bf16_t* qw, const bf16_t* Kb, const bf16_t* Vb, int ta_lo, int ta_n, int tb_lo, int tb_n, bf16x8 (&qr)[4]) {
    int tid_l = threadIdx.x; asm volatile("" : "+v"(tid_l));
    const int tid = tid_l, lane = tid & 63, r32 = lane & 31, hi = lane >> 5, wid = __builtin_amdgcn_readfirstlane(tid >> 6);
    const int kkey = wid * 8 + (lane >> 3), kc = (lane & 7) ^ ((kkey >> 1) & 7);
    const size_t ksrc = (size_t)kkey * 64 + kc * 8;
    const size_t vsrc = (size_t)(16 * (wid & 3) + (lane >> 2)) * 64 + 32 * (wid >> 2) + (lane & 3) * 8;
#pragma unroll
    for (int s = 0; s < 4; ++s) qr[s] = *(const bf16x8*)(qw + (size_t)r32 * 64 + s * 16 + hi * 8);
    const unsigned lds0 = (unsigned)(uintptr_t)lds; const int ntile = ta_n + tb_n;
#pragma unroll
    for (int t = 0; t < 2; ++t) if (t < ntile) { const int T_ = t < ta_n ? ta_lo + t : tb_lo + t - ta_n; const unsigned so_ = lds0 + (unsigned)((t & 3) * 16384 + wid * 1024);
        glds16(Kb + (size_t)T_ * 4096 + ksrc, (unsigned)__builtin_amdgcn_readfirstlane(so_));
        glds16(Vb + (size_t)T_ * 4096 + vsrc, (unsigned)__builtin_amdgcn_readfirstlane(so_ + 8192u)); }
}

__device__ __forceinline__ void store_ot(bf16_t* yrow  , const f32x16 (&v)[2], int hi) {
#pragma unroll
    for (int d0 = 0; d0 < 2; ++d0)
#pragma unroll
        for (int g4 = 0; g4 < 4; ++g4) { u32x2 w; w.x = pg8::cvt_pk_bf16(v[d0][4 * g4], v[d0][4 * g4 + 1]); w.y = pg8::cvt_pk_bf16(v[d0][4 * g4 + 2], v[d0][4 * g4 + 3]);
            *(u32x2*)(yrow + d0 * 32 + 8 * g4 + 4 * hi) = w; }
}

__device__ __forceinline__ void store_ot_lds(bf16_t* yrow0  , const f32x16 (&v)[2], int lane, LAS unsigned char* stage) {
    const int r32 = lane & 31, hi = lane >> 5;
#pragma unroll
    for (int d0 = 0; d0 < 2; ++d0)
#pragma unroll
        for (int g4 = 0; g4 < 4; ++g4) { u32x2 w; w.x = pg8::cvt_pk_bf16(v[d0][4 * g4], v[d0][4 * g4 + 1]); w.y = pg8::cvt_pk_bf16(v[d0][4 * g4 + 2], v[d0][4 * g4 + 3]);
            *(LAS u32x2*)(stage + r32 * 144 + (d0 * 32 + 8 * g4 + 4 * hi) * 2) = w; }
    asm volatile("s_waitcnt lgkmcnt(0)" ::: "memory");
    u32x4 q[4];
#pragma unroll
    for (int j = 0; j < 4; ++j) q[j] = *(const LAS u32x4*)(stage + ((lane >> 3) + 8 * j) * 144 + (lane & 7) * 16);
#pragma unroll
    for (int j = 0; j < 4; ++j) *(u32x4*)(yrow0 + (size_t)((lane >> 3) + 8 * j) * D + (lane & 7) * 8) = q[j];
}

#ifndef REP_C
#define REP_C 1
#endif
#ifndef REP_AB
#define REP_AB 1
#endif
#ifndef MIX_DYNQ
#define MIX_DYNQ 1
#endif
__device__ __forceinline__ void mixers_phase(Frame& F, int l) {
    const bool ctxside = (l == 0);
#define MIX_LAUNDER() int tidm_ = threadIdx.x; asm volatile("" : "+v"(tidm_)); const int lane = tidm_ & 63, r32 = lane & 31, hi = lane >> 5, wv = __builtin_amdgcn_readfirstlane(tidm_ >> 6); \
    unsigned char* r1; { GAS unsigned char* r1g_ = (GAS unsigned char*)(F.ws + WS_R1); asm volatile("" : "+s"(r1g_)); r1 = (unsigned char*)r1g_; } bf16_t* Y = (bf16_t*)(r1 + R1_H);
    for (int repc_ = 0; repc_ < REP_C; ++repc_) { if (repc_) __syncthreads();
        MIX_LAUNDER();
        const bf16_t *QC = (const bf16_t*)(r1 + R1_QC), *KC = (const bf16_t*)(r1 + R1_KC), *VC = (const bf16_t*)(r1 + R1_VC);
        const float lam_init = (l == 0) ? 0.2f : 0.3555090675909693f;
        float lam;
        { float a = (lane < 32) ? INP(I_LQ1)[l * 32 + lane] * INP(I_LK1)[l * 32 + lane] : 0.f, b = (lane < 32) ? INP(I_LQ2)[l * 32 + lane] * INP(I_LK2)[l * 32 + lane] : 0.f;
            lam = __expf(wave_sum(a)) - __expf(wave_sum(b)) + lam_init; }
        const int nC = 512 + (ctxside ? 8 : 0);
        for (int u = F.bid; u < nC; u += F.G) {
            int bh, pos0, ta_n; size_t yrow0;
            if (u < 512) { bh = u & 7; const int qb = u >> 3; pos0 = CTX + qb * 256 + wv * 32; ta_n = KEYS / 64; yrow0 = (size_t)(bh >> 2) * SEQ + qb * 256 + wv * 32; }
            else { bh = u - 512; pos0 = wv * 32; ta_n = CTX / 64; yrow0 = (size_t)NLAT + (bh >> 2) * CTX + wv * 32; }
            f32x16 o[2][2]; float ls[2];
            bool fast;
            { const unsigned* bw = (const unsigned*)(F.ws + WS_CTL) + CW_BND + l * 128;
              const float q0 = __uint_as_float(__hip_atomic_load(bw + bh * 2, RLX_AGENT)), q1 = __uint_as_float(__hip_atomic_load(bw + bh * 2 + 1, RLX_AGENT));
              const float k0 = __uint_as_float(__hip_atomic_load(bw + 16 + bh * 2, RLX_AGENT)), k1 = __uint_as_float(__hip_atomic_load(bw + 16 + bh * 2 + 1, RLX_AGENT));
              fast = (q0 * k0 < 3600.f) && (q1 * k1 < 3600.f); fast = __builtin_amdgcn_readfirstlane(fast ? 1 : 0) != 0; }
            bf16x8 qrc[4];
            if (fast) attn_fast<2>(F.lds, QC + ((size_t)bh * KEYS + pos0) * 64, KC + (size_t)bh * KEYS * 64, VC + (size_t)bh * KEYS * 64, 0, ta_n, 0, 0, -1, 0.f, o, ls, qrc);
            else attn_unit<2>(F.lds, QC + ((size_t)bh * KEYS + pos0) * 64, KC + (size_t)bh * KEYS * 64, VC + (size_t)bh * KEYS * 64, 0, ta_n, 0, 0, -1, NEGBIG, 0.f, o, ls);
            const float i1 = 1.f / ls[0], i2 = lam / ls[1];
            f32x16 v[2]; float ss = 0.f;
#pragma unroll
            for (int d0 = 0; d0 < 2; ++d0)
#pragma unroll
                for (int r = 0; r < 16; ++r) { const float x = o[0][d0][r] * i1 - o[1][d0][r] * i2; v[d0][r] = x; ss += x * x; }
            ss = xor32_sum(ss);
            const float rn = (1.f - lam_init) / sqrtf(ss * (1.f / 64.f) + EPS);
            const float* gs = INP(I_GSUB) + l * 64;
#pragma unroll
            for (int d0 = 0; d0 < 2; ++d0)
#pragma unroll
                for (int r = 0; r < 16; ++r) v[d0][r] *= rn * gs[d0 * 32 + crow(r, hi)];
            store_ot(Y + (yrow0 + r32) * D + 768 + (bh & 3) * 64, v, hi);
        }
    }
    for (int repa_ = 0; repa_ < REP_AB; ++repa_) { if (repa_) __syncthreads();
        MIX_LAUNDER();
        const bf16_t *QA = (const bf16_t*)(r1 + R1_QA), *KA = (const bf16_t*)(r1 + R1_KA), *VA = (const bf16_t*)(r1 + R1_VA);
        unsigned okmask = 0u;
        { const unsigned* bw = (const unsigned*)(F.ws + WS_CTL) + CW_BND + l * 128;
          for (int bhd = 0; bhd < 16; ++bhd) { const int b2 = bhd >> 3, hd = bhd & 7, kv = hd >> 2;
              const float kk = __uint_as_float(__hip_atomic_load(bw + 64 + b2 * 4 + kv * 2, RLX_AGENT)) + __uint_as_float(__hip_atomic_load(bw + 64 + b2 * 4 + kv * 2 + 1, RLX_AGENT));
              const float qq = __uint_as_float(__hip_atomic_load(bw + 32 + b2 * 16 + hd * 2, RLX_AGENT)) + __uint_as_float(__hip_atomic_load(bw + 32 + b2 * 16 + hd * 2 + 1, RLX_AGENT));
              const bool ok = (qq * kk < 3600.f) && (fabsf(INP(I_SINK)[l * 8 + hd]) * LOG2E < 60.f);
              okmask |= (ok ? 1u : 0u) << bhd; }
          okmask = (unsigned)__builtin_amdgcn_readfirstlane((int)okmask); }
        const int nA = 1024 + (ctxside ? 16 : 0);
        const int nCv = (l == 0 && MIX_DYNQ) ? CV_UNITS : 0, nQ = nA + nCv;
        unsigned* qctrA = (unsigned*)(F.ws + WS_CTL) + CW_MIXQ + l * 2 + repa_ * 4;
        volatile LAS int* qw_ = (volatile LAS int*)(F.lds + TBL_OFF);
        int qnxt = 0; if (tidm_ == 0) qnxt = (int)__hip_atomic_fetch_add(qctrA, 1u, __ATOMIC_RELAXED, __HIP_MEMORY_SCOPE_AGENT);
        auto pop = [&]() -> int { if (tidm_ == 0) { qw_[0] = qnxt; } __syncthreads(); int u = qw_[0]; __syncthreads();
            if (u < nQ && tidm_ == 0) qnxt = (int)__hip_atomic_fetch_add(qctrA, 1u, __ATOMIC_RELAXED, __HIP_MEMORY_SCOPE_AGENT);
            return __builtin_amdgcn_readfirstlane(u); };
        struct AU { int b, head, pos0, qlat, tb_lo, tb_n; size_t yrow0; bool fast; };
        auto decode = [&](int u, AU& a) -> int {
            if (u >= nQ) return 0;
            if (nCv) { const int cvb = (u * nCv) / nQ, cva = ((u + 1) * nCv) / nQ; if (cva != cvb) { a.b = cvb; return 2; } u -= cvb; }
            unsigned need;
            if (u < 1024) { const int kvg = u & 1, i = (u >> 1) & 255; a.b = u >> 9; a.head = 4 * kvg + (wv >> 1); const int q0 = i * 64 + (wv & 1) * 32;
                a.pos0 = CTX + q0; a.qlat = q0 + r32; const int tlo = max(i - 2, 0), thi = min(i + 2, SEQ / 64 - 1); a.tb_lo = 4 + tlo; a.tb_n = thi - tlo + 1; a.yrow0 = (size_t)a.b * SEQ + q0; need = 0xFu << (a.b * 8 + 4 * kvg); }
            else { const int q = u - 1024; a.b = q >> 3; a.head = q & 7; a.pos0 = wv * 32; a.qlat = -1; a.tb_lo = 0; a.tb_n = 0; a.yrow0 = (size_t)NLAT + a.b * CTX + wv * 32; need = 1u << (a.b * 8 + a.head); }
            a.fast = (okmask & need) == need;
            return 1; };
#define AQ(a) (QA + ((size_t)((a).b * 8 + (a).head) * KEYS + (a).pos0) * 64)
#define AK(a) (KA + (size_t)((a).b * 2 + ((a).head >> 2)) * KEYS * 64)
#define AV(a) (VA + (size_t)((a).b * 2 + ((a).head >> 2)) * KEYS * 64)
        AU cur; int kind = decode(pop(), cur); bool pre = false; bf16x8 qr[4];
        while (kind) {
            if (kind == 2) { p0_items(F, P0_EARLY + cur.b * CV_PER_UNIT + wv, NWAVES, CV_PER_UNIT / NWAVES, (LAS float*)(F.lds + wv * 16384), lane); kind = decode(pop(), cur); pre = false; continue; }
            f32x16 o[1][2]; float ls[1];
            const float sink2 = INP(I_SINK)[l * 8 + cur.head] * LOG2E;
            if (cur.fast) { const float li = hi == 0 ? __builtin_amdgcn_exp2f(sink2) : 0.f;
                if (pre) attn_fast<1, true, 8>(F.lds, AQ(cur), AK(cur), AV(cur), 0, CTX / 64, cur.tb_lo, cur.tb_n, cur.qlat, li, o, ls, qr);
                else { attn_fast<1, false, 0, A_LEAD>(F.lds, AQ(cur), AK(cur), AV(cur), 0, CTX / 64, cur.tb_lo, cur.tb_n, cur.qlat, li, o, ls, qr);
#if PROBE_A2
                    asm volatile("" :: "v"(o[0][0]), "v"(o[0][1]), "v"(ls[0]) : "memory"); attn_fast<1, false, 0, A_LEAD>(F.lds, AQ(cur), AK(cur), AV(cur), 0, CTX / 64, cur.tb_lo, cur.tb_n, cur.qlat, li, o, ls, qr);
#endif
                } }
            else attn_unit<1>(F.lds, AQ(cur), AK(cur), AV(cur), 0, CTX / 64, cur.tb_lo, cur.tb_n, cur.qlat, sink2, hi == 0 ? 1.f : 0.f, o, ls);
            AU nx; const int kn = decode(pop(), nx); const bool pren = (A_LEAD == 2) && (kn == 1) && nx.fast;
            if (pren) af_begin(F.lds, AQ(nx), AK(nx), AV(nx), 0, CTX / 64, nx.tb_lo, nx.tb_n, qr);
            const float inv = 1.f / ls[0];
            f32x16 v[2]; v[0] = o[0][0] * inv; v[1] = o[0][1] * inv;
            store_ot(Y + (cur.yrow0 + r32) * D + cur.head * 64, v, hi);
            cur = nx; kind = kn; pre = pren;
        }
#undef AQ
#undef AK
#undef AV
    }
    for (int repb_ = 0; repb_ < REP_AB; ++repb_) { if (repb_) __syncthreads();
        MIX_LAUNDER();
        const bf16_t *BU = (const bf16_t*)(r1 + R1_BU), *BV = (const bf16_t*)(r1 + R1_BV);
        const int nB = (ctxside ? NROW / 128 : NLAT / 128) * 4;
        LAS bf16_t* vnT = (LAS bf16_t*)F.lds;
        const bf16_t* WS = (const bf16_t*)(F.ws + WS_WSTOK) + (size_t)l * 4 * 128 * 128;
        unsigned* qctrB = (unsigned*)(F.ws + WS_CTL) + CW_MIXQ + l * 2 + 1 + repb_ * 4;
        volatile LAS int* qw_ = (volatile LAS int*)(F.lds + TBL_OFF);
        int qnxt = 0; if (MIX_DYNQ && tidm_ == 0) qnxt = (int)__hip_atomic_fetch_add(qctrB, 1u, __ATOMIC_RELAXED, __HIP_MEMORY_SCOPE_AGENT);
        for (int u = (F.bid + F.G - 24) % F.G; ; u += F.G) {
            if (MIX_DYNQ) { if (tidm_ == 0) { qw_[0] = qnxt; } __syncthreads(); u = qw_[0]; __syncthreads();
                if (u < nB && tidm_ == 0) qnxt = (int)__hip_atomic_fetch_add(qctrB, 1u, __ATOMIC_RELAXED, __HIP_MEMORY_SCOPE_AGENT); }
            u = __builtin_amdgcn_readfirstlane(u);
            if (u >= nB) break;
            const int g = u & 3, rc = u >> 2, row0 = rc * 128;
            { const int ftid = tidm_;
                const int p = ftid >> 2, dq = ftid & 3;
                const u32x4* src = (const u32x4*)(BV + (size_t)(row0 + p) * 256 + g * 64 + dq * 16);
                const u32x4 a = src[0], b4 = src[1]; float x[16];
                x[0] = bflo(a.x); x[1] = bfhi(a.x); x[2] = bflo(a.y); x[3] = bfhi(a.y); x[4] = bflo(a.z); x[5] = bfhi(a.z); x[6] = bflo(a.w); x[7] = bfhi(a.w);
                x[8] = bflo(b4.x); x[9] = bfhi(b4.x); x[10] = bflo(b4.y); x[11] = bfhi(b4.y); x[12] = bflo(b4.z); x[13] = bfhi(b4.z); x[14] = bflo(b4.w); x[15] = bfhi(b4.w);
                float s = 0.f;
#pragma unroll
                for (int i = 0; i < 16; ++i) { x[i] = gelu_tanh(x[i]); s += x[i]; }
                s += __shfl_xor(s, 1); s += __shfl_xor(s, 2);
                const float mu = s * (1.f / 64.f); float q = 0.f;
#pragma unroll
                for (int i = 0; i < 16; ++i) { x[i] -= mu; q += x[i] * x[i]; }
                q += __shfl_xor(q, 1); q += __shfl_xor(q, 2);
                const float rs = 1.f / sqrtf(q * (1.f / 64.f) + EPS);
                const float* gt = INP(I_GTOK) + (l * 4 + g) * 64 + dq * 16;
#pragma unroll
                for (int i = 0; i < 16; ++i) vnT[(dq * 16 + i) * 136 + p] = (bf16_t)(pg8::cvt_pk_bf16(x[i] * rs * gt[i], 0.f) & 0xffffu);
            }
            __syncthreads();
            const int pblk = wv >> 1, dblk = wv & 1;
            f32x16 acc = f32x16{};
            const bf16_t* wsr = WS + ((size_t)g * 128 + pblk * 32 + r32) * 128 + hi * 8;
#pragma unroll
            for (int s = 0; s < 8; ++s) { const bf16x8 wf = *(const bf16x8*)(wsr + s * 16);
                const bf16x8 vfr = *(const LAS bf16x8*)(vnT + (dblk * 32 + r32) * 136 + s * 16 + hi * 8);
                acc = __builtin_amdgcn_mfma_f32_32x32x16_bf16(vfr, wf, acc, 0, 0, 0); }
            const int p = pblk * 32 + r32;
            const float bsp = INP(I_BSTOK)[(l * 4 + g) * 128 + p];
            const bf16_t* up = BU + (size_t)(row0 + p) * 256 + g * 64 + dblk * 32 + 4 * hi;
            bf16_t* yp = Y + (size_t)(row0 + p) * D + 512 + g * 64 + dblk * 32 + 4 * hi;
#pragma unroll
            for (int g4 = 0; g4 < 4; ++g4) { const u32x2 uw = *(const u32x2*)(up + 8 * g4);
                const float y0 = gelu_tanh(bflo(uw.x)) * (acc[4 * g4] + bsp), y1 = gelu_tanh(bfhi(uw.x)) * (acc[4 * g4 + 1] + bsp), y2 = gelu_tanh(bflo(uw.y)) * (acc[4 * g4 + 2] + bsp), y3 = gelu_tanh(bfhi(uw.y)) * (acc[4 * g4 + 3] + bsp);
                *(u32x2*)(yp + 8 * g4) = (u32x2){pg8::cvt_pk_bf16(y0, y1), pg8::cvt_pk_bf16(y2, y3)}; }
            __syncthreads();
        }
    }
}

#ifndef REP_N0
#define REP_N0 1
#endif
#ifndef REP_P0
#define REP_P0 1
#endif
#ifndef REP_RT
#define REP_RT 1
#endif
#ifndef REP_PM
#define REP_PM 1
#endif
#ifndef REP_GEMM
#define REP_GEMM 1
#endif
#ifndef REP_MIX
#define REP_MIX 1
#endif
#ifndef MOE_MERGE
#define MOE_MERGE 1
#endif
struct Args { const float* in[27]; float* out; unsigned char* ws; int ph_lo, ph_hi; };
__global__ void __launch_bounds__(NTHR, 2) fwd_kernel(Args args) {
    extern __shared__ __attribute__((aligned(16))) unsigned char lds_raw[];
    Frame F;
    F.lds = (LAS unsigned char*)lds_raw;
    F.tid = threadIdx.x; F.lane = F.tid & 63; F.wave = __builtin_amdgcn_readfirstlane(F.tid >> 6);
    F.G = gridDim.x; F.bid = blockIdx.x;
    F.out = args.out; F.ws = args.ws;
    volatile LAS unsigned* MISC = (volatile LAS unsigned*)(F.lds + MISC_OFF);
    for (int u = F.tid; u < 64; u += NTHR) MISC[u] = 0u;
    __syncthreads();
    const int lo = args.ph_lo, hi = args.ph_hi;
    unsigned* barw = (unsigned*)(F.ws + WS_CTL) + CW_BAR;
    XcdBarrier bar; bar.bar = barw; bar.x = 0; bar.st = nullptr;
    const bool multi = (hi - lo) > 1;
    if (multi) bar = xcd_barrier_post(barw, MISC + 8);
#ifdef ONLY_PH
#define IN(k) (((k) == 0 ? 0 : (((k) - 1) % 8) + 1) == ONLY_PH && lo <= (k) && (k) < hi)
#else
#define IN(k) (lo <= (k) && (k) < hi)
#endif
#define SEAM(k) do { if (IN(k) && IN((k) + 1)) xcd_barrier(bar); LAUNDER(); } while (0)
#define LAUNDER() do { asm volatile("" : "+v"(F.tid), "+v"(F.lane)); asm volatile("" : "+s"(F.wave), "+s"(F.G), "+s"(F.bid)); { GAS unsigned char* ws_ = (GAS unsigned char*)F.ws; GAS float* out_ = (GAS float*)F.out; asm volatile("" : "+s"(ws_), "+s"(out_)); F.ws = (unsigned char*)ws_; F.out = (float*)out_; } } while (0)
    LAS int* tb = (LAS int*)(F.lds + TBL_OFF);

    LAUNDER();
    if (IN(0)) for (int rep_ = 0; rep_ < REP_P0; ++rep_) { if (rep_) { __syncthreads(); LAUNDER(); } p0_prologue(F); } SEAM(0);
    for (int l = 0; l < 2; ++l) {
        const int pb = 1 + 8 * l;
        const int Mlay = (l == 0) ? NROW : NLAT;
        if (IN(pb + 0)) { if (l == 0) { for (int rep_ = 0; rep_ < REP_N0; ++rep_) { if (rep_) LAUNDER(); norm_phase<0>(F, l); } } else norm_phase<1>(F, l);
        } SEAM(pb + 0);
        if (IN(pb + 1)) for (int rep_ = 0; rep_ < REP_GEMM; ++rep_) {
            if (rep_) { __syncthreads(); LAUNDER(); }
            pg8::Gemm g{(const bf16_t*)(F.ws + WS_R1 + R1_H), (const bf16_t*)(F.ws + WS_WIN) + (size_t)l * DIN * D, NROW, DIN, D, 0, nullptr};
            pg8::StaticOrder S; S.init(NLAT, DIN, F.G, F.bid);
            EpiProj E{F.ws + WS_R1, (const f32x2*)(F.ws + WS_TABA), (const f32x2*)(F.ws + WS_TABC), (unsigned*)(F.ws + WS_CTL) + CW_BND + l * 128};
            pg8::gemm_phase<EpiProj, pg8::StaticOrder, true, true>(F.lds, g, S, E);
            { LAUNDER(); CtxEpiProj CE{F.ws + WS_R1, (unsigned*)(F.ws + WS_CTL) + CW_BND + l * 128};
              ctx_gemm<CtxEpiProj>(F, (const bf16_t*)(F.ws + WS_R1 + R1_H) + (size_t)NLAT * D, (const bf16_t*)(F.ws + WS_WIN) + (size_t)l * DIN * D, DIN, CE); }
        } SEAM(pb + 1);
        if (IN(pb + 2)) for (int rep_ = 0; rep_ < REP_MIX; ++rep_) { if (rep_) { __syncthreads(); LAUNDER(); } mixers_phase(F, l); } SEAM(pb + 2);
        if (IN(pb + 3)) {
            pg8::Gemm g{(const bf16_t*)(F.ws + WS_R1 + R1_H), (const bf16_t*)(F.ws + WS_WOUT) + (size_t)l * D * D, NLAT, D, D, 0, nullptr};
            pg8::StaticOrder S; S.init(NLAT, D, F.G, F.bid);
            EpiOut E{l == 0 ? INP(I_X) : (const float*)nullptr, (bf16_t*)(F.ws + WS_XS), (const float*)(F.ws + WS_MOD) + (size_t)l * 3 * 6144};
            pg8::gemm_phase<EpiOut, pg8::StaticOrder, true, true>(F.lds, g, S, E);
            if (l == 0) { LAUNDER(); CtxEpiOut CE{INP(I_CTX), (bf16_t*)(F.ws + WS_XS) + (size_t)NLAT * D, (const float*)(F.ws + WS_MOD) + (size_t)(l * 3 + 2) * 6144 + 2 * D};
              ctx_gemm<CtxEpiOut>(F, (const bf16_t*)(F.ws + WS_R1 + R1_H) + (size_t)NLAT * D, (const bf16_t*)(F.ws + WS_WOUT) + (size_t)l * D * D, D, CE); }
        } SEAM(pb + 3);
        if (IN(pb + 4)) for (int rep_ = 0; rep_ < REP_RT; ++rep_) { if (rep_) { __syncthreads(); LAUNDER(); } route_phase(F, l, Mlay); } SEAM(pb + 4);
        if (IN(pb + 5)) for (int rep_ = 0; rep_ < REP_PM; ++rep_) { if (rep_) { __syncthreads(); LAUNDER(); } permute_phase(F, l, Mlay); } SEAM(pb + 5);
        if (IN(pb + 6)) for (int rep_ = 0; rep_ < REP_GEMM; ++rep_) {
            LAUNDER(); __syncthreads(); load_tile_bases(F, l, tb);
            LAS int* gmap = (LAS int*)(F.lds + GMAP_OFF);
            GroupedOrder S{4, F.G, F.bid, tb[NEXP] * 4, tb, MOE_MERGE ? (unsigned*)(F.ws + WS_CTL) + CW_MOEC + l * 8192 : (unsigned*)nullptr};
            { pg8::Unit uu; const int* ROWMAP = (const int*)(F.ws + WS_ROWMAP);
              for (int i = 0; i < GMAP_UNITS && S.next(i, uu); ++i) if (F.tid < 256) gmap[i * 256 + F.tid] = ROWMAP[uu.pm * 256 + F.tid];
              __syncthreads(); }
            pg8::Gemm g{(const bf16_t*)(F.ws + WS_R1 + R1_H2), (const bf16_t*)(F.ws + WS_WGU) + (size_t)l * NEXP * 1024 * D, MOE_ROWS, 1024, D, (size_t)1024 * D * 2, gmap};
            EpiMoe1 E{(bf16_t*)(F.ws + WS_R1 + R1_HE)};
            pg8::gemm_phase<EpiMoe1, GroupedOrder, true, true, true>(F.lds, g, S, E);
        } if (!MOE_MERGE) SEAM(pb + 6); else LAUNDER();
        if (IN(pb + 7)) for (int rep_ = 0; rep_ < REP_GEMM; ++rep_) {
            LAUNDER(); __syncthreads(); load_tile_bases(F, l, tb);
            pg8::Gemm g{(const bf16_t*)(F.ws + WS_R1 + R1_HE), (const bf16_t*)(F.ws + WS_WD) + (size_t)l * NEXP * D * DEXP, MOE_ROWS, D, DEXP, (size_t)D * DEXP * 2, nullptr};
#if MOE_MERGE
            GroupedOrder2 S{F.G, F.bid, tb[NEXP] * 4, tb, (unsigned*)(F.ws + WS_CTL) + CW_MOEC + l * 8192};
#else
            GroupedOrder S{4, F.G, F.bid, tb[NEXP] * 4, tb, nullptr};
#endif
            EpiMoe2 E{(bf16_t*)(F.ws + WS_R2), (const int*)(F.ws + WS_ROWMAP), (const float*)(F.ws + WS_WSLOT)};
#if MOE_MERGE
            pg8::gemm_phase<EpiMoe2, GroupedOrder2, true, true>(F.lds, g, S, E);
#else
            pg8::gemm_phase<EpiMoe2, GroupedOrder, true, true>(F.lds, g, S, E);
#endif
        } SEAM(pb + 7);
    }
    if (IN(17)) { norm_phase<2>(F, 1); }
#undef IN
#undef SEAM
}

#ifndef MK_PER_PHASE
#define MK_PER_PHASE 0
#endif
extern "C" void kernel_launch(void* const* d_in, const int* in_sizes, int n_in, void* d_out, int out_size, void* d_ws, size_t ws_size, hipStream_t stream) {
    static int grid = 0;
    if (grid == 0) {
        if (n_in != 27 || out_size != NLAT * D || ws_size < WS_END) { fprintf(stderr, "kernel_launch: unexpected problem (n_in %d out %d ws %zu)\n", n_in, out_size, ws_size); grid = -1; return; }
        if (hipFuncSetAttribute((const void*)fwd_kernel, hipFuncAttributeMaxDynamicSharedMemorySize, LDS_BYTES) != hipSuccess) { fprintf(stderr, "kernel_launch: hipFuncSetAttribute failed\n"); grid = -1; return; }
        int dev = 0, cus = 0, per_cu = 0;
        if (hipGetDevice(&dev) != hipSuccess || hipDeviceGetAttribute(&cus, hipDeviceAttributeMultiprocessorCount, dev) != hipSuccess) { grid = -1; return; }
        if (hipOccupancyMaxActiveBlocksPerMultiprocessor(&per_cu, (const void*)fwd_kernel, NTHR, LDS_BYTES) != hipSuccess || per_cu < 1) fprintf(stderr, "kernel_launch: occupancy query says %d\n", per_cu);
        (void)hipGetLastError();
        grid = cus < 256 ? cus : 256;
    }
    if (grid < 0) return;
    if (hipMemsetAsync((char*)d_ws + WS_CTL, 0, CTL_ZERO_BYTES, stream) != hipSuccess) return;
    Args a{};
    for (int i = 0; i < 27; ++i) a.in[i] = (const float*)d_in[i];
    a.out = (float*)d_out; a.ws = (unsigned char*)d_ws;
#if MK_PER_PHASE
    for (int p = 0; p < N_PHASES; ++p) { a.ph_lo = p; a.ph_hi = p + 1; hipLaunchKernelGGL(fwd_kernel, dim3(grid), dim3(NTHR), LDS_BYTES, stream, a); }
#else
    a.ph_lo = 0; a.ph_hi = N_PHASES;
    hipLaunchKernelGGL(fwd_kernel, dim3(grid), dim3(NTHR), LDS_BYTES, stream, a);
#endif
}
```
